# Optimizing an MI355X kernel written in HIP

```python
import jax, jax.numpy as jnp
from jax import lax
import numpy as np

D_MODEL = 1024
BATCH = 8
SEQ = 4096
DEPTH = 4

GRID_W = 64
CTX_LEN = 256
HEAD_DIM = 64
A_HEADS = (D_MODEL // HEAD_DIM) // 2
A_KV_HEADS = 2
A_WIDTH = A_HEADS * HEAD_DIM
B_HEADS = (D_MODEL // HEAD_DIM) // 2
B_WIDTH = B_HEADS * HEAD_DIM
DECAY_LORA = 64
ICLR_LORA = 64
GATE_LORA = 128
C_HEADS = D_MODEL // HEAD_DIM
C_KV_HEADS = 4
C_WIDTH = C_HEADS * HEAD_DIM
WINDOW = 128
Q_BLOCK = 128
D_FF = 2816
N_MOD = 9
ROPE_THETA = 10000.0
EPS = 1e-6
GN_EPS = 64e-5
NEG_BIG = -1e30

A_COLS = A_WIDTH + 2 * A_KV_HEADS * HEAD_DIM
A_SPLITS = (A_WIDTH, A_WIDTH + A_KV_HEADS * HEAD_DIM)
RWKV_COLS = 3 * B_WIDTH + 2 * DECAY_LORA + 2 * ICLR_LORA + GATE_LORA
RWKV_SPLITS = (B_WIDTH, 2 * B_WIDTH, 3 * B_WIDTH, 3 * B_WIDTH + 2 * DECAY_LORA,
               3 * B_WIDTH + 2 * DECAY_LORA + 2 * ICLR_LORA)
EVEN_COLS = A_COLS + RWKV_COLS
ODD_COLS = C_WIDTH + 2 * C_KV_HEADS * HEAD_DIM
ODD_SPLITS = (C_WIDTH, C_WIDTH + C_KV_HEADS * HEAD_DIM)

kernel_name = "hybrid_dit_gqa_rwkv7_swa_macaron"


def rms_norm(x, gain=None):
    xf = x.astype(jnp.float32)
    y = xf * lax.rsqrt(jnp.mean(xf * xf, axis=-1, keepdims=True) + EPS)
    if gain is not None:
        y = y * gain
    return y.astype(x.dtype)


def modulate(h, shift, scale):
    return h * (1.0 + scale) + shift


def swiglu(h, w_in, w_out):
    gate, up = jnp.split(h @ w_in, 2, axis=-1)
    return (jax.nn.silu(gate) * up) @ w_out


def axial_rope_tables(n_tokens):
    rows = n_tokens // GRID_W
    row = jnp.repeat(jnp.arange(rows, dtype=jnp.float32), GRID_W)
    col = jnp.tile(jnp.arange(GRID_W, dtype=jnp.float32), rows)
    n_freq = HEAD_DIM // 4
    inv_freq = ROPE_THETA ** (-jnp.arange(n_freq, dtype=jnp.float32) / n_freq)
    ang = jnp.concatenate([row[:, None] * inv_freq, col[:, None] * inv_freq], axis=-1)
    return jnp.cos(ang), jnp.sin(ang)


def apply_rope(x, cos, sin):
    xp = x.reshape(*x.shape[:-1], HEAD_DIM // 2, 2)
    x0, x1 = xp[..., 0], xp[..., 1]
    c = cos[None, :, None, :].astype(x.dtype)
    s = sin[None, :, None, :].astype(x.dtype)
    return jnp.stack([x0 * c - x1 * s, x0 * s + x1 * c], axis=-1).reshape(x.shape)


def attend(q, k, v):
    s = jnp.einsum('bqhgd,bkhd->bhgqk', q, k).astype(jnp.float32)
    p = jax.nn.softmax(s, axis=-1).astype(v.dtype)
    return jnp.einsum('bhgqk,bkhd->bqhgd', p, v)


def global_gqa(q_l, k_l, v_l, q_c, k_c, v_c, ctx_out):
    Bsz, N = q_l.shape[:2]
    G = A_HEADS // A_KV_HEADS
    scale = HEAD_DIM ** -0.5
    k_all = jnp.concatenate([k_l, k_c], axis=1)
    v_all = jnp.concatenate([v_l, v_c], axis=1)
    qb = (q_l * scale).reshape(Bsz, N // Q_BLOCK, Q_BLOCK, A_KV_HEADS, G, HEAD_DIM).swapaxes(0, 1)
    o_lat = lax.map(lambda qblk: attend(qblk, k_all, v_all), qb)
    o_lat = o_lat.swapaxes(0, 1).reshape(Bsz, N, A_WIDTH)
    o_ctx = None
    if ctx_out:
        L = q_c.shape[1]
        qc = (q_c * scale).reshape(Bsz, L, A_KV_HEADS, G, HEAD_DIM)
        o_ctx = attend(qc, k_c, v_c).reshape(Bsz, L, A_WIDTH)
    return o_lat, o_ctx


def window_gqa(q_l, k_l, v_l, q_c, k_c, v_c, sink, ctx_out):
    Bsz, N = q_l.shape[:2]
    G = C_HEADS // C_KV_HEADS
    scale = HEAD_DIM ** -0.5
    nb = N // Q_BLOCK
    span = Q_BLOCK + 2 * WINDOW
    pad = ((0, 0), (WINDOW, WINDOW), (0, 0), (0, 0))
    k_pad = jnp.pad(k_l, pad)
    v_pad = jnp.pad(v_l, pad)
    qb = (q_l * scale).reshape(Bsz, nb, Q_BLOCK, C_KV_HEADS, G, HEAD_DIM).swapaxes(0, 1)
    sink_hg = sink.reshape(C_KV_HEADS, G).astype(jnp.float32)
    q_off = jnp.arange(Q_BLOCK)
    k_off = jnp.arange(span) - WINDOW
    in_window = jnp.abs(k_off[None, :] - q_off[:, None]) <= WINDOW

    def softmax_with_sink(s):
        sink_col = jnp.broadcast_to(sink_hg[None, :, :, None, None], s.shape[:-1] + (1,))
        return jax.nn.softmax(jnp.concatenate([s, sink_col], axis=-1), axis=-1)[..., :-1]

    def block(args):
        b, qblk = args
        start = b * Q_BLOCK
        kb = lax.dynamic_slice_in_dim(k_pad, start, span, axis=1)
        vb = lax.dynamic_slice_in_dim(v_pad, start, span, axis=1)
        kpos = start - WINDOW + k_off
        valid = in_window & ((kpos >= 0) & (kpos < N))[None, :]
        s_win = jnp.einsum('bqhgd,bkhd->bhgqk', qblk, kb).astype(jnp.float32)
        s_win = jnp.where(valid, s_win, NEG_BIG)
        s_ctx = jnp.einsum('bqhgd,bkhd->bhgqk', qblk, k_c).astype(jnp.float32)
        p = softmax_with_sink(jnp.concatenate([s_win, s_ctx], axis=-1)).astype(vb.dtype)
        return (jnp.einsum('bhgqk,bkhd->bqhgd', p[..., :span], vb)
                + jnp.einsum('bhgqk,bkhd->bqhgd', p[..., span:], v_c))

    o_lat = lax.map(block, (jnp.arange(nb), qb)).swapaxes(0, 1).reshape(Bsz, N, C_WIDTH)
    o_ctx = None
    if ctx_out:
        L = q_c.shape[1]
        qc = (q_c * scale).reshape(Bsz, L, C_KV_HEADS, G, HEAD_DIM)
        s = jnp.einsum('bqhgd,bkhd->bhgqk', qc, k_c).astype(jnp.float32)
        p = softmax_with_sink(s).astype(v_c.dtype)
        o_ctx = jnp.einsum('bhgqk,bkhd->bqhgd', p, v_c).reshape(Bsz, L, C_WIDTH)
    return o_lat, o_ctx


def centred_shift(f, mu):
    prev = jnp.pad(f[:, :-1], ((0, 0), (1, 0), (0, 0)))
    nxt = jnp.pad(f[:, 1:], ((0, 0), (0, 1), (0, 0)))
    return f + mu[0] * (prev - f) + mu[1] * (nxt - f)


def rwkv7_features(f, mu, w0, w2, a0, a2, g2, k_k, k_a):
    Bsz, T, _ = f.shape
    f = centred_shift(f, mu)
    r, k, v, wl, al, gl = jnp.split(f, RWKV_SPLITS, axis=-1)
    heads = lambda t: t.reshape(Bsz, T, B_HEADS, HEAD_DIM)
    dir_heads = lambda t: t.reshape(Bsz, T, 2, B_HEADS, HEAD_DIM)
    kk = heads(k * k_k).astype(jnp.float32)
    kk = kk * lax.rsqrt(jnp.sum(kk * kk, axis=-1, keepdims=True) + EPS)
    w_log = (w0 + jnp.einsum('btdr,drc->btdc', jnp.tanh(wl.reshape(Bsz, T, 2, DECAY_LORA)), w2)).astype(jnp.float32)
    decay = jnp.exp(-jnp.exp(-jax.nn.softplus(-w_log) - 0.5))
    a = jax.nn.sigmoid((a0 + jnp.einsum('btdr,drc->btdc', al.reshape(Bsz, T, 2, ICLR_LORA), a2)).astype(jnp.float32))
    k_dir = k[:, :, None, :].astype(jnp.float32) * (1.0 + (a - 1.0) * k_a)
    g = jax.nn.sigmoid(gl) @ g2
    return (heads(r), heads(k), heads(v), kk, g, dir_heads(decay), dir_heads(a), dir_heads(k_dir))


def wkv7_scan(S0, inputs, reverse):
    xs = tuple(jnp.swapaxes(t.astype(jnp.float32), 0, 1) for t in inputs)

    def step(S, inp):
        r, w, k, v, kk, a = inp
        S = (S * w[:, :, None, :]
             - jnp.einsum('bhvk,bhk->bhv', S, kk)[..., None] * (kk * a)[:, :, None, :]
             + v[..., None] * k[:, :, None, :])
        return S, jnp.einsum('bhvk,bhk->bhv', S, r)

    S, y = lax.scan(step, S0, xs, reverse=reverse)
    return S, jnp.swapaxes(y, 0, 1)


def rwkv7_readout(y, feat, r_k, gn_w, gn_b):
    r, k, v, _, g = feat[:5]
    Bsz, T = y.shape[:2]
    mean = jnp.mean(y, axis=-1, keepdims=True)
    var = jnp.mean(jnp.square(y - mean), axis=-1, keepdims=True)
    yn = ((y - mean) * lax.rsqrt(var + GN_EPS)).reshape(Bsz, T, B_WIDTH) * gn_w + gn_b
    bonus = (jnp.sum(r * k * r_k, axis=-1, keepdims=True) * v).reshape(Bsz, T, B_WIDTH)
    return ((yn + bonus.astype(jnp.float32)) * g.astype(jnp.float32)).astype(g.dtype)


def rwkv7_bidir(f_lat, f_ctx, r_k, gn_w, gn_b, ctx_out):
    Bsz = f_lat[0].shape[0]
    S0 = jnp.zeros((Bsz, B_HEADS, HEAD_DIM, HEAD_DIM), jnp.float32)

    def dir_inputs(f, d):
        r, _, v, kk, _, decay, a, k_dir = f
        return (r, decay[:, :, d], k_dir[:, :, d], v, kk, a[:, :, d])

    S_cf, y_cf = wkv7_scan(S0, dir_inputs(f_ctx, 0), reverse=False)
    S_cb, y_cb = wkv7_scan(S0, dir_inputs(f_ctx, 1), reverse=True)
    _, y_lf = wkv7_scan(S_cf, dir_inputs(f_lat, 0), reverse=False)
    _, y_lb = wkv7_scan(S_cb, dir_inputs(f_lat, 1), reverse=True)
    o_lat = rwkv7_readout(y_lf + y_lb, f_lat, r_k, gn_w, gn_b)
    o_ctx = rwkv7_readout(y_cf + y_cb, f_ctx, r_k, gn_w, gn_b) if ctx_out else None
    return o_lat, o_ctx


def even_mixer(h_lat, h_ctx, cos, sin, w_in, w_out, q_gain, k_gain, mu, w0, w2, a0, a2, g2,
               k_k, k_a, r_k, gn_w, gn_b, ctx_out):
    Bsz, N, _ = h_lat.shape
    L = h_ctx.shape[1]
    p_lat = h_lat @ w_in
    p_ctx = h_ctx @ w_in

    def qkv_a(p, T):
        q, k, v = jnp.split(p[..., :A_COLS], A_SPLITS, axis=-1)
        q = rms_norm(q.reshape(Bsz, T, A_HEADS, HEAD_DIM), q_gain)
        k = rms_norm(k.reshape(Bsz, T, A_KV_HEADS, HEAD_DIM), k_gain)
        return q, k, v.reshape(Bsz, T, A_KV_HEADS, HEAD_DIM)

    q_l, k_l, v_l = qkv_a(p_lat, N)
    q_c, k_c, v_c = qkv_a(p_ctx, L)
    oa_lat, oa_ctx = global_gqa(apply_rope(q_l, cos, sin), apply_rope(k_l, cos, sin), v_l,
                                q_c, k_c, v_c, ctx_out)
    f_lat = rwkv7_features(p_lat[..., A_COLS:], mu, w0, w2, a0, a2, g2, k_k, k_a)
    f_ctx = rwkv7_features(p_ctx[..., A_COLS:], mu, w0, w2, a0, a2, g2, k_k, k_a)
    ob_lat, ob_ctx = rwkv7_bidir(f_lat, f_ctx, r_k, gn_w, gn_b, ctx_out)
    o_lat = jnp.concatenate([oa_lat, ob_lat], axis=-1) @ w_out
    o_ctx = jnp.concatenate([oa_ctx, ob_ctx], axis=-1) @ w_out if ctx_out else None
    return o_lat, o_ctx


def odd_mixer(h_lat, h_ctx, cos, sin, w_in, w_out, sink, ctx_out):
    Bsz, N, _ = h_lat.shape
    L = h_ctx.shape[1]

    def qkv_c(h, T):
        q, k, v = jnp.split(h @ w_in, ODD_SPLITS, axis=-1)
        return (q.reshape(Bsz, T, C_HEADS, HEAD_DIM), k.reshape(Bsz, T, C_KV_HEADS, HEAD_DIM),
                v.reshape(Bsz, T, C_KV_HEADS, HEAD_DIM))

    q_l, k_l, v_l = qkv_c(h_lat, N)
    q_c, k_c, v_c = qkv_c(h_ctx, L)
    o_lat, o_ctx = window_gqa(apply_rope(q_l, cos, sin), apply_rope(k_l, cos, sin), v_l,
                              q_c, k_c, v_c, sink, ctx_out)
    return o_lat @ w_out, (o_ctx @ w_out if ctx_out else None)


def setup_inputs(seed: int = 0) -> dict:
    key = jax.random.key(seed)
    ks = iter(jax.random.split(key, 32))
    nrm = lambda shape, s: s * jax.random.normal(next(ks), shape, jnp.float32)
    uni = lambda shape, lo, hi: jax.random.uniform(next(ks), shape, jnp.float32, lo, hi)
    n_even = (DEPTH + 1) // 2
    n_odd = DEPTH // 2
    D = D_MODEL
    return {
        "x": nrm((BATCH, SEQ, D), 1.0),
        "c": nrm((BATCH, D), 1.0),
        "ctx": nrm((BATCH, CTX_LEN, D), 1.0),
        "c_ctx": nrm((D,), 1.0),
        "w_mod": nrm((DEPTH, D, N_MOD * D), 0.5 * D ** -0.5),
        "b_mod": nrm((DEPTH, N_MOD * D), 0.02),
        "ffn_in": nrm((DEPTH, 2, D, 2 * D_FF), D ** -0.5),
        "ffn_out": nrm((DEPTH, 2, D_FF, D), D_FF ** -0.5),
        "even_w_in": nrm((n_even, D, EVEN_COLS), D ** -0.5),
        "even_w_out": nrm((n_even, A_WIDTH + B_WIDTH, D), (A_WIDTH + B_WIDTH) ** -0.5),
        "q_gain": 1.0 + nrm((n_even, HEAD_DIM), 0.05),
        "k_gain": 1.0 + nrm((n_even, HEAD_DIM), 0.05),
        "rwkv_mu": uni((n_even, 2, RWKV_COLS), 0.0, 0.5),
        "rwkv_w0": uni((n_even, 2, B_WIDTH), -4.0, 1.0),
        "rwkv_w2": nrm((n_even, 2, DECAY_LORA, B_WIDTH), 0.1),
        "rwkv_a0": nrm((n_even, 2, B_WIDTH), 0.5),
        "rwkv_a2": nrm((n_even, 2, ICLR_LORA, B_WIDTH), 0.1),
        "rwkv_g2": nrm((n_even, GATE_LORA, B_WIDTH), GATE_LORA ** -0.5),
        "rwkv_k_k": 0.85 + nrm((n_even, B_WIDTH), 0.05),
        "rwkv_k_a": 1.0 + nrm((n_even, B_WIDTH), 0.05),
        "rwkv_r_k": nrm((n_even, B_HEADS, HEAD_DIM), 0.1),
        "rwkv_gn_w": 1.0 + nrm((n_even, B_WIDTH), 0.05),
        "rwkv_gn_b": nrm((n_even, B_WIDTH), 0.02),
        "odd_w_in": nrm((n_odd, D, ODD_COLS), D ** -0.5),
        "odd_w_out": nrm((n_odd, C_WIDTH, D), C_WIDTH ** -0.5),
        "sink": nrm((n_odd, C_HEADS), 1.0),
        "final_gain": 1.0 + nrm((D,), 0.05),
    }


def reference(x, c, ctx, c_ctx, w_mod, b_mod, ffn_in, ffn_out, even_w_in, even_w_out, q_gain, k_gain,
              rwkv_mu, rwkv_w0, rwkv_w2, rwkv_a0, rwkv_a2, rwkv_g2, rwkv_k_k, rwkv_k_a, rwkv_r_k,
              rwkv_gn_w, rwkv_gn_b, odd_w_in, odd_w_out, sink, final_gain):
    Bsz, N, D = x.shape
    cos, sin = axial_rope_tables(N)
    silu_c = jax.nn.silu(c)
    silu_cc = jax.nn.silu(c_ctx)
    for l in range(DEPTH):
        ctx_out = l < DEPTH - 1
        m_lat = (silu_c @ w_mod[l] + b_mod[l]).reshape(Bsz, N_MOD, 1, D)
        m_ctx = (silu_cc @ w_mod[l] + b_mod[l]).reshape(N_MOD, D)
        x = x + 0.5 * m_lat[:, 2] * swiglu(modulate(rms_norm(x), m_lat[:, 0], m_lat[:, 1]), ffn_in[l, 0], ffn_out[l, 0])
        ctx = ctx + 0.5 * m_ctx[2] * swiglu(modulate(rms_norm(ctx), m_ctx[0], m_ctx[1]), ffn_in[l, 0], ffn_out[l, 0])
        h_lat = modulate(rms_norm(x), m_lat[:, 3], m_lat[:, 4])
        h_ctx = modulate(rms_norm(ctx), m_ctx[3], m_ctx[4])
        if l % 2 == 0:
            e = l // 2
            o_lat, o_ctx = even_mixer(h_lat, h_ctx, cos, sin, even_w_in[e], even_w_out[e], q_gain[e], k_gain[e],
                                      rwkv_mu[e], rwkv_w0[e], rwkv_w2[e], rwkv_a0[e], rwkv_a2[e], rwkv_g2[e],
                                      rwkv_k_k[e], rwkv_k_a[e], rwkv_r_k[e], rwkv_gn_w[e], rwkv_gn_b[e], ctx_out)
        else:
            o = l // 2
            o_lat, o_ctx = odd_mixer(h_lat, h_ctx, cos, sin, odd_w_in[o], odd_w_out[o], sink[o], ctx_out)
        x = x + m_lat[:, 5] * o_lat
        x = x + 0.5 * m_lat[:, 8] * swiglu(modulate(rms_norm(x), m_lat[:, 6], m_lat[:, 7]), ffn_in[l, 1], ffn_out[l, 1])
        if ctx_out:
            ctx = ctx + m_ctx[5] * o_ctx
            ctx = ctx + 0.5 * m_ctx[8] * swiglu(modulate(rms_norm(ctx), m_ctx[6], m_ctx[7]), ffn_in[l, 1], ffn_out[l, 1])
    return rms_norm(x, final_gain)
```

```cpp
#include <hip/hip_runtime.h>
#include <hip/hip_cooperative_groups.h>
#include <cstdio>
namespace cg = cooperative_groups;

#ifndef MEGA
#define MEGA 0
#endif

typedef unsigned short u16;
using bf16x8 = __attribute__((ext_vector_type(8))) short;
using f32x4  = __attribute__((ext_vector_type(4))) float;
using f32x16 = __attribute__((ext_vector_type(16))) float;
#define DI __device__ __forceinline__

constexpr int D = 1024, MLAT = 32768, MCTX = 2048, MTOT = 34816, NTOK = 4352;
constexpr int DFF = 2816, EVC = 2688, EVCP = 2816, ODC = 1536, RW = 768;
constexpr int NPH = 51;
constexpr int LDS_BYTES = 131072;

constexpr size_t WS_FFI = 0;
constexpr size_t WS_FFO = WS_FFI + (size_t)8 * 5632 * 1024 * 2;
constexpr size_t WS_EVI = WS_FFO + (size_t)8 * 1024 * 2816 * 2;
constexpr size_t WS_EVO = WS_EVI + (size_t)2 * 2816 * 1024 * 2;
constexpr size_t WS_ODI = WS_EVO + (size_t)2 * 1024 * 1024 * 2;
constexpr size_t WS_ODO = WS_ODI + (size_t)2 * 1536 * 1024 * 2;
constexpr size_t WS_MOD = WS_ODO + (size_t)2 * 1024 * 1024 * 2;
constexpr size_t WS_XCTX = WS_MOD + (size_t)4 * 9 * 9216 * 4;
constexpr size_t WS_H = WS_XCTX + (size_t)MCTX * D * 4;
constexpr size_t WS_ACT = WS_H + (size_t)MTOT * D * 2;
constexpr size_t WS_Q = WS_ACT + (size_t)MTOT * DFF * 2;
constexpr size_t WS_K = WS_Q + (size_t)8 * 16 * NTOK * 64 * 2;
constexpr size_t WS_VT = WS_K + (size_t)8 * 4 * NTOK * 64 * 2;
constexpr size_t WS_Y = WS_VT + (size_t)8 * 4 * NTOK * 64 * 2;
constexpr size_t WS_CNT = WS_Y + (size_t)MTOT * 2 * 512 * 2;
constexpr size_t WS_END = WS_CNT + 256;

struct Params {
  const float* in[27];
  float* out;
  unsigned char* ws;
};

extern __shared__ __attribute__((aligned(16))) unsigned char g_lds[];

DI int otid() { int t = threadIdx.x; asm volatile("" : "+v"(t)); return t; }
DI int obid() { int b = blockIdx.x; asm volatile("" : "+s"(b)); return b; }
DI u16 f2bf(float f) { unsigned u = __float_as_uint(f); u += 0x7fffu + ((u >> 16) & 1u); return (u16)(u >> 16); }
DI float bf2f(u16 h) { return __uint_as_float(((unsigned)h) << 16); }
DI unsigned pack2(float a, float b) { return (unsigned)f2bf(a) | ((unsigned)f2bf(b) << 16); }
DI float wave_sum(float v) {
#pragma unroll
  for (int o = 32; o >= 1; o >>= 1) v += __shfl_xor(v, o);
  return v;
}
DI float* xrow(const Params& p, int row) {
  return row < MLAT ? p.out + (size_t)row * D : (float*)(p.ws + WS_XCTX) + (size_t)(row - MLAT) * D;
}

DI void convert_tile(const float* src, int ld_src, u16* dst, int ld_dst, int k0, int nsrc0, int ndst0) {
  float* t = (float*)g_lds;
  const int tid = otid();
#pragma unroll
  for (int it = 0; it < 2; ++it) {
    int idx = tid + it * 512; int i = idx >> 4, j4 = idx & 15;
    float4 v = *(const float4*)(src + (size_t)(k0 + i) * ld_src + nsrc0 + j4 * 4);
    t[(j4 * 4 + 0) * 65 + i] = v.x; t[(j4 * 4 + 1) * 65 + i] = v.y; t[(j4 * 4 + 2) * 65 + i] = v.z; t[(j4 * 4 + 3) * 65 + i] = v.w;
  }
  __syncthreads();
  int n = tid >> 3, kq = tid & 7;
  const float* r = t + n * 65 + kq * 8;
  uint4 o; o.x = pack2(r[0], r[1]); o.y = pack2(r[2], r[3]); o.z = pack2(r[4], r[5]); o.w = pack2(r[6], r[7]);
  *(uint4*)(dst + (size_t)(ndst0 + n) * ld_dst + k0 + kq * 8) = o;
  __syncthreads();
}

__device__ void phase_setup(const Params& p) {
  const int tid = otid();
  const int N_FFI = 8 * 16 * 88, N_FFO = 8 * 44 * 16, N_EVI = 2 * 16 * 42, N_EVO = 2 * 256, N_ODI = 2 * 16 * 24, N_ODO = 2 * 256;
  const int total = N_FFI + N_FFO + N_EVI + N_EVO + N_ODI + N_ODO;
  for (int it = obid(); it < total; it += gridDim.x) {
    int t = it;
    if (t < N_FFI) {
      int m = t / 1408, r = t % 1408; int kt = r & 15, nt = r >> 4;
      int nd = nt * 64; int t256 = nd >> 8, half = (nd >> 7) & 1, c0 = nd & 127;
      convert_tile(p.in[6] + (size_t)m * 1024 * 5632, 5632, (u16*)(p.ws + WS_FFI) + (size_t)m * 5632 * 1024, 1024, kt * 64, half * 2816 + t256 * 128 + c0, nd);
      continue;
    }
    t -= N_FFI;
    if (t < N_FFO) {
      int m = t / 704, r = t % 704; int kt = r % 44, nt = r / 44;
      convert_tile(p.in[7] + (size_t)m * 2816 * 1024, 1024, (u16*)(p.ws + WS_FFO) + (size_t)m * 1024 * 2816, 2816, kt * 64, nt * 64, nt * 64);
      continue;
    }
    t -= N_FFO;
    if (t < N_EVI) {
      int m = t / 672, r = t % 672; int kt = r & 15, nt = r >> 4;
      convert_tile(p.in[8] + (size_t)m * 1024 * EVC, EVC, (u16*)(p.ws + WS_EVI) + (size_t)m * EVCP * 1024, 1024, kt * 64, nt * 64, nt * 64);
      continue;
    }
    t -= N_EVI;
    if (t < N_EVO) {
      int m = t / 256, r = t % 256; int kt = r & 15, nt = r >> 4;
      convert_tile(p.in[9] + (size_t)m * 1024 * 1024, 1024, (u16*)(p.ws + WS_EVO) + (size_t)m * 1024 * 1024, 1024, kt * 64, nt * 64, nt * 64);
      continue;
    }
    t -= N_EVO;
    if (t < N_ODI) {
      int m = t / 384, r = t % 384; int kt = r & 15, nt = r >> 4;
      convert_tile(p.in[23] + (size_t)m * 1024 * ODC, ODC, (u16*)(p.ws + WS_ODI) + (size_t)m * ODC * 1024, 1024, kt * 64, nt * 64, nt * 64);
      continue;
    }
    t -= N_ODI;
    {
      int m = t / 256, r = t % 256; int kt = r & 15, nt = r >> 4;
      convert_tile(p.in[24] + (size_t)m * 1024 * 1024, 1024, (u16*)(p.ws + WS_ODO) + (size_t)m * 1024 * 1024, 1024, kt * 64, nt * 64, nt * 64);
    }
  }
  for (int i = obid() * 512 + tid; i < 2 * 128 * 1024 / 8; i += gridDim.x * 512) {
    int m = i / (128 * 128), r = i % (128 * 128);
    *(uint4*)((u16*)(p.ws + WS_EVI) + (size_t)m * EVCP * 1024 + (size_t)EVC * 1024 + (size_t)r * 8) = make_uint4(0, 0, 0, 0);
  }
  {
    const float4* xs = (const float4*)p.in[0]; float4* xd = (float4*)p.out;
    for (size_t i = (size_t)obid() * 512 + tid; i < (size_t)MLAT * D / 4; i += (size_t)gridDim.x * 512) xd[i] = xs[i];
    const float4* cs = (const float4*)p.in[2]; float4* cd = (float4*)(p.ws + WS_XCTX);
    for (size_t i = (size_t)obid() * 512 + tid; i < (size_t)MCTX * D / 4; i += (size_t)gridDim.x * 512) cd[i] = cs[i];
  }
  if (obid() == 0 && tid < 64) ((unsigned*)(p.ws + WS_CNT))[tid] = 0u;
}

__device__ void phase_mod(const Params& p) {
  const int tid = otid();
  float* sc = (float*)g_lds;
  float* red = sc + 9 * 1024;
  for (int i = tid; i < 9 * 1024; i += 512) {
    int e = i >> 10, k = i & 1023; float v = e < 8 ? p.in[1][e * 1024 + k] : p.in[3][k];
    sc[i] = v / (1.f + __expf(-v));
  }
  __syncthreads();
  float* mod = (float*)(p.ws + WS_MOD);
  for (int tile = obid(); tile < 576; tile += gridDim.x) {
    int l = tile / 144, cgp = tile % 144;
    int cl = tid & 63, kg = tid >> 6;
    const float* w = p.in[4] + (size_t)l * 1024 * 9216 + cgp * 64 + cl;
    float acc[9];
#pragma unroll
    for (int e = 0; e < 9; ++e) acc[e] = 0.f;
    for (int k = kg * 128; k < kg * 128 + 128; ++k) {
      float wv = w[(size_t)k * 9216];
#pragma unroll
      for (int e = 0; e < 9; ++e) acc[e] += sc[e * 1024 + k] * wv;
    }
#pragma unroll
    for (int e = 0; e < 9; ++e) red[(kg * 9 + e) * 64 + cl] = acc[e];
    __syncthreads();
    for (int o = tid; o < 576; o += 512) {
      int e = o >> 6, cc = o & 63; float s = 0.f;
#pragma unroll
      for (int k2 = 0; k2 < 8; ++k2) s += red[(k2 * 9 + e) * 64 + cc];
      mod[(size_t)(l * 9 + e) * 9216 + cgp * 64 + cc] = s + p.in[5][l * 9216 + cgp * 64 + cc];
    }
    __syncthreads();
  }
}

__device__ void phase_prep(const Params& p, int l, int sh, int nrows) {
  const int tid_ = otid(); const int lane = tid_ & 63, wave = tid_ >> 6;
  u16* H = (u16*)(p.ws + WS_H);
  const float* modl = (const float*)(p.ws + WS_MOD) + (size_t)l * 9 * 9216;
  for (int row = obid() * 8 + wave; row < nrows; row += gridDim.x * 8) {
    const float4* xr = (const float4*)xrow(p, row);
    int e = row < MLAT ? row >> 12 : 8;
    const float* m = modl + (size_t)e * 9216;
    float4 v[4]; float ss = 0.f;
#pragma unroll
    for (int q = 0; q < 4; ++q) { v[q] = xr[lane + q * 64]; ss += v[q].x * v[q].x + v[q].y * v[q].y + v[q].z * v[q].z + v[q].w * v[q].w; }
    ss = wave_sum(ss);
    float rstd = rsqrtf(ss * (1.f / 1024.f) + 1e-6f);
#pragma unroll
    for (int q = 0; q < 4; ++q) {
      int col = (lane + q * 64) * 4;
      float4 s4 = *(const float4*)(m + sh * 1024 + col), c4 = *(const float4*)(m + (sh + 1) * 1024 + col);
      uint2 o;
      o.x = pack2(v[q].x * rstd * (1.f + c4.x) + s4.x, v[q].y * rstd * (1.f + c4.y) + s4.y);
      o.y = pack2(v[q].z * rstd * (1.f + c4.z) + s4.z, v[q].w * rstd * (1.f + c4.w) + s4.w);
      *(uint2*)(H + (size_t)row * D + col) = o;
    }
  }
}

namespace pg8 {
#define PG8_LAS __attribute__((address_space(3)))
typedef unsigned short bf16_t;
typedef unsigned u32x4 __attribute__((ext_vector_type(4)));
constexpr int BM = 256, BK = 64, HALF = 128, HTB = HALF * BK * 2, STAGE_BYTES = 8 * HTB, NXCD = 8, WGM = 8;
__host__ __device__ __forceinline__ int lds_byte(int r, int c) { const int st = (r >> 4) * 2 + (c >> 5), rr = r & 15, cc = c & 31, ob = rr * 64 + cc * 2; return st * 1024 + (ob ^ (((ob >> 9) & 1) << 5)); }
__host__ __device__ __forceinline__ void stage_rc(int b, int& R, int& C) { const int st = b / 1024, sb = b % 1024, swz = sb ^ (((sb >> 9) & 1) << 5); R = (st >> 1) * 16 + swz / 64; C = (st & 1) * 32 + (swz % 64) / 2; }
__host__ __device__ __forceinline__ int perm32(int rho) { const int n = rho >> 4, i = rho & 15; return 8 * (i >> 2) + 4 * n + (i & 3); }
struct Unit { int pm, pn; };
struct Gemm { const bf16_t* A; const bf16_t* Bt; int M, N, K; };
struct StaticOrder {
    int nM, nN, nwg, G, c;
    __host__ __device__ void init(int M, int N, int G_, int c_) { nM = M / BM; nN = N / BM; nwg = nM * nN; G = G_; c = c_; }
    __host__ __device__ bool next(int i, Unit& u) const {
        const long L = (long)i * G + c; if (L >= nwg) return false;
        int wgid = (int)L; { const int q = nwg / NXCD, r = nwg % NXCD, xcd = wgid % NXCD, off = wgid / NXCD; wgid = (xcd < r ? xcd * (q + 1) : r * (q + 1) + (xcd - r) * q) + off; }
        const int nig = WGM * nN, gid = wgid / nig, fm = gid * WGM, gsz = (nM - fm) < WGM ? (nM - fm) : WGM;
        u.pm = fm + ((wgid % nig) % gsz); u.pn = (wgid % nig) / gsz; return true;
    }
    __device__ __forceinline__ void a_ready(const Unit&) const {}
    __device__ __forceinline__ void done(const Unit&) const {}
};
template <class Epi, class Sched, bool STAMP = false>
__device__ __forceinline__ void gemm_phase(PG8_LAS unsigned char* lds, const Gemm g, const Sched& S, const Epi& E, unsigned long long* stamps) {
    const int tid = otid(), wid = __builtin_amdgcn_readfirstlane(tid >> 6), lane = tid & 63, wr = wid >> 2, wc = wid & 3, fr = lane & 15, fq = lane >> 4;
    const int K = g.K, nt = K / BK;
    int ts_lo = 0, ts_hi = 0, nts = 0; const unsigned long long rt_entry = STAMP ? (unsigned long long)wall_clock64() : 0ull;
#define PG8_STAMP() do { if (STAMP && wid == 0 && nts < 64) { const unsigned long long _c = (unsigned long long)clock64(); \
        ts_lo = (lane == nts) ? (int)(unsigned)_c : ts_lo; ts_hi = (lane == nts) ? (int)(unsigned)(_c >> 32) : ts_hi; ++nts; } } while (0)
    PG8_STAMP();
    unsigned voffA[2], voffB[2];
#pragma unroll
    for (int i = 0; i < 2; ++i) { int R, C; stage_rc(tid * 16 + i * 8192, R, C); const int Rb = Epi::PERM ? ((R & ~31) + perm32(R & 31)) : R;
        voffA[i] = (unsigned)(R * K + C) * 2u; voffB[i] = (unsigned)(Rb * K + C) * 2u; }
    const size_t kstep = (size_t)(BK * 2);
    const size_t hstep = (size_t)HALF * K * 2;
    const size_t tstep = 2 * hstep;
    const unsigned ldsw = (unsigned)wid * 1024u;
    const int aoff = lds_byte(wr * 64 + fr, fq * 8), boff = lds_byte(wc * 32 + fr, fq * 8);
#define PG8_SA(b, h) (((b) * 2 + (h)) * HTB)
#define PG8_SB(b, h) ((4 + (b) * 2 + (h)) * HTB)
#define PG8_STAGE(bufoff, gbase, voff) do { _Pragma("unroll") for (int _i = 0; _i < 2; ++_i) \
        __builtin_amdgcn_global_load_lds((const unsigned*)((const char*)(gbase) + (voff)[_i]), (PG8_LAS unsigned*)(lds + (bufoff) + ldsw + _i * 8192), 16, 0, 0); } while (0)
#define PG8_LDA(dst, b, h) do { _Pragma("unroll") for (int m = 0; m < 4; ++m) _Pragma("unroll") for (int k = 0; k < 2; ++k) dst[m][k] = *(const PG8_LAS bf16x8*)(lds + PG8_SA(b, h) + aoff + m * 2048 + k * 1024); } while (0)
#define PG8_LDB(dst, b, h) do { _Pragma("unroll") for (int n = 0; n < 2; ++n) _Pragma("unroll") for (int k = 0; k < 2; ++k) dst[n][k] = *(const PG8_LAS bf16x8*)(lds + PG8_SB(b, h) + boff + n * 2048 + k * 1024); } while (0)
#define PG8_MMA(ai, bj, At, Bt) do { __builtin_amdgcn_s_setprio(1); _Pragma("unroll") for (int m = 0; m < 4; ++m) _Pragma("unroll") for (int n = 0; n < 2; ++n) _Pragma("unroll") for (int k = 0; k < 2; ++k) \
        acc[ai][bj][m][n] = __builtin_amdgcn_mfma_f32_16x16x32_bf16(Bt[n][k], At[m][k], acc[ai][bj][m][n], 0, 0, 0); __builtin_amdgcn_s_setprio(0); } while (0)
#define PG8_WAIT_V(n) asm volatile("s_waitcnt vmcnt(" #n ")" ::: "memory")
#define PG8_WAIT_L(n) asm volatile("s_waitcnt lgkmcnt(" #n ")" ::: "memory")
#define PG8_BAR __builtin_amdgcn_s_barrier()
#define PG8_SCHED __builtin_amdgcn_sched_barrier(0)
    Unit cur, nxt; int ui = 0;
    if (!S.next(0, cur)) return;
    f32x4 acc[2][2][4][2];
#pragma unroll
    for (int a = 0; a < 2; ++a)
#pragma unroll
        for (int b = 0; b < 2; ++b)
#pragma unroll
            for (int m = 0; m < 4; ++m)
#pragma unroll
                for (int n = 0; n < 2; ++n) acc[a][b][m][n] = (f32x4){0.f, 0.f, 0.f, 0.f};
    bf16x8 At[4][2], B0[2][2], B1[2][2];
    const char* cA = (const char*)g.A + (size_t)cur.pm * tstep; const char* cB = (const char*)g.Bt + (size_t)cur.pn * tstep;
    S.a_ready(cur);
    PG8_STAGE(PG8_SB(0, 0), cB, voffB); PG8_STAGE(PG8_SA(0, 0), cA, voffA); PG8_STAGE(PG8_SB(0, 1), cB + hstep, voffB); PG8_STAGE(PG8_SA(0, 1), cA + hstep, voffA);
    if (wr == 1) PG8_BAR;
    PG8_WAIT_V(4); PG8_BAR;
    PG8_STAGE(PG8_SB(1, 0), cB + kstep, voffB); PG8_STAGE(PG8_SA(1, 0), cA + kstep, voffA); PG8_STAGE(PG8_SB(1, 1), cB + hstep + kstep, voffB);
    PG8_WAIT_V(6); PG8_BAR;
    PG8_STAMP();
    for (;;) {
        const bool has_next = S.next(ui + 1, nxt);
        const char* nA = has_next ? (const char*)g.A + (size_t)nxt.pm * tstep : cA; const char* nB = has_next ? (const char*)g.Bt + (size_t)nxt.pn * tstep : cB;
        for (int t = 0; t < nt; t += 2) {
            const bool last = (t == nt - 2);
            const char* a1 = cA + (size_t)(t + 1) * kstep;
            const char* a2 = last ? nA : cA + (size_t)(t + 2) * kstep; const char* b2 = last ? nB : cB + (size_t)(t + 2) * kstep;
            const char* a3 = a2 + kstep; const char* b3 = b2 + kstep;
            if (last && has_next) S.a_ready(nxt);
            PG8_LDB(B0, 0, 0); PG8_SCHED; PG8_LDA(At, 0, 0); PG8_STAGE(PG8_SA(1, 1), a1 + hstep, voffA);
            PG8_WAIT_L(8); PG8_BAR; PG8_WAIT_L(0); PG8_MMA(0, 0, At, B0); PG8_BAR; PG8_SCHED;
            PG8_LDB(B1, 0, 1); PG8_STAGE(PG8_SB(0, 0), b2, voffB);
            PG8_BAR; PG8_WAIT_L(0); PG8_MMA(0, 1, At, B1); PG8_BAR;
            PG8_LDA(At, 0, 1); PG8_STAGE(PG8_SA(0, 0), a2, voffA);
            PG8_BAR; PG8_WAIT_L(0); PG8_MMA(1, 0, At, B0); PG8_BAR; PG8_SCHED;
            PG8_STAGE(PG8_SB(0, 1), b2 + hstep, voffB);
            PG8_WAIT_V(6); PG8_BAR; PG8_MMA(1, 1, At, B1); PG8_BAR;
            PG8_LDB(B0, 1, 0); PG8_SCHED; PG8_LDA(At, 1, 0); PG8_STAGE(PG8_SA(0, 1), a2 + hstep, voffA);
            PG8_WAIT_L(8); PG8_BAR; PG8_WAIT_L(0); PG8_MMA(0, 0, At, B0); PG8_BAR; PG8_SCHED;
            PG8_LDB(B1, 1, 1); PG8_STAGE(PG8_SB(1, 0), b3, voffB);
            PG8_BAR; PG8_WAIT_L(0); PG8_MMA(0, 1, At, B1); PG8_BAR;
            PG8_LDA(At, 1, 1); PG8_STAGE(PG8_SA(1, 0), a3, voffA);
            PG8_BAR; PG8_WAIT_L(0); PG8_MMA(1, 0, At, B0); PG8_BAR; PG8_SCHED;
            PG8_STAGE(PG8_SB(1, 1), b3 + hstep, voffB);
            PG8_WAIT_V(6); PG8_BAR; PG8_MMA(1, 1, At, B1); PG8_BAR;
        }
        PG8_STAMP();
        if constexpr (!Epi::AFTER_DRAIN) { E(acc, cur, wr, wc, fr, fq); S.done(cur); }
        PG8_STAMP();
        if (!has_next) break;
#pragma unroll
        for (int a = 0; a < 2; ++a)
#pragma unroll
            for (int b = 0; b < 2; ++b)
#pragma unroll
                for (int m = 0; m < 4; ++m)
#pragma unroll
                    for (int n = 0; n < 2; ++n) acc[a][b][m][n] = (f32x4){0.f, 0.f, 0.f, 0.f};
        cur = nxt; cA = nA; cB = nB; ++ui;
    }
    PG8_WAIT_V(0);
    if (wr == 0) PG8_BAR;
    PG8_BAR;
    if constexpr (Epi::AFTER_DRAIN) { E.fused(acc, cur, wr, wc, fr, fq, lds, wid, lane); S.done(cur); }
    PG8_STAMP();
    if (STAMP && wid == 0) { stamps[lane] = lane < nts ? (((unsigned long long)(unsigned)ts_hi << 32) | (unsigned)ts_lo) : 0ull;
        if (lane == 62) stamps[62] = rt_entry; if (lane == 63) stamps[63] = (unsigned long long)wall_clock64(); }
#undef PG8_STAMP
#undef PG8_SA
#undef PG8_SB
#undef PG8_STAGE
#undef PG8_LDA
#undef PG8_LDB
#undef PG8_MMA
#undef PG8_WAIT_V
#undef PG8_WAIT_L
#undef PG8_BAR
#undef PG8_SCHED
}
}

struct EpiAct {
  static constexpr bool PERM = true, AFTER_DRAIN = false;
  u16* act;
  DI void operator()(const f32x4 (&acc)[2][2][4][2], const pg8::Unit& u, int wr, int wc, int fr, int fq) const {
    const int row0 = u.pm * 256 + wr * 64 + fr, col0 = u.pn * 128 + wc * 32 + 8 * fq;
#pragma unroll
    for (int ai = 0; ai < 2; ++ai)
#pragma unroll
      for (int m = 0; m < 4; ++m) {
        u16* rowp = act + (size_t)(row0 + ai * 128 + m * 16) * DFF + col0;
        float o[8];
#pragma unroll
        for (int n = 0; n < 2; ++n)
#pragma unroll
          for (int j = 0; j < 4; ++j) { float g = acc[ai][0][m][n][j], up = acc[ai][1][m][n][j]; o[n * 4 + j] = g / (1.f + __expf(-g)) * up; }
        uint4 w; w.x = pack2(o[0], o[1]); w.y = pack2(o[2], o[3]); w.z = pack2(o[4], o[5]); w.w = pack2(o[6], o[7]);
        *(uint4*)rowp = w;
      }
  }
};
struct EpiRes {
  static constexpr bool PERM = false, AFTER_DRAIN = false;
  float* xlat; float* xctx; const float* modl; int gidx; float coef;
  DI void operator()(const f32x4 (&acc)[2][2][4][2], const pg8::Unit& u, int wr, int wc, int fr, int fq) const {
    const int brow = u.pm * 256;
    const int e = brow < MLAT ? brow >> 12 : 8;
    float* xb = (brow < MLAT ? xlat + (size_t)brow * D : xctx + (size_t)(brow - MLAT) * D) + (size_t)(wr * 64 + fr) * D;
    const int col0 = u.pn * 256 + wc * 32 + 4 * fq;
    const float* mg = modl + (size_t)e * 9216 + gidx * 1024 + col0;
    f32x4 gm[2][2];
#pragma unroll
    for (int bj = 0; bj < 2; ++bj)
#pragma unroll
      for (int n = 0; n < 2; ++n) gm[bj][n] = *(const f32x4*)(mg + bj * 128 + n * 16) * coef;
#pragma unroll
    for (int ai = 0; ai < 2; ++ai)
#pragma unroll
      for (int m = 0; m < 4; ++m) {
        float* rowp = xb + (size_t)(ai * 128 + m * 16) * D + col0;
#pragma unroll
        for (int bj = 0; bj < 2; ++bj)
#pragma unroll
          for (int n = 0; n < 2; ++n) {
            f32x4* xp = (f32x4*)(rowp + bj * 128 + n * 16);
            *xp = *xp + gm[bj][n] * acc[ai][bj][m][n];
          }
      }
  }
};
struct EpiP {
  static constexpr bool PERM = true, AFTER_DRAIN = false;
  u16* P; int ld; int nvalid;
  DI void operator()(const f32x4 (&acc)[2][2][4][2], const pg8::Unit& u, int wr, int wc, int fr, int fq) const {
    const int row0 = u.pm * 256 + wr * 64 + fr, col0 = u.pn * 256 + wc * 32 + 8 * fq;
#pragma unroll
    for (int ai = 0; ai < 2; ++ai)
#pragma unroll
      for (int m = 0; m < 4; ++m) {
        u16* rowp = P + (size_t)(row0 + ai * 128 + m * 16) * ld + col0;
#pragma unroll
        for (int bj = 0; bj < 2; ++bj) {
          if (col0 + bj * 128 < nvalid) {
            const f32x4 v0 = acc[ai][bj][m][0], v1 = acc[ai][bj][m][1];
            uint4 w; w.x = pack2(v0[0], v0[1]); w.y = pack2(v0[2], v0[3]); w.z = pack2(v1[0], v1[1]); w.w = pack2(v1[2], v1[3]);
            *(uint4*)(rowp + bj * 128) = w;
          }
        }
      }
  }
};

template <class Epi>
DI void gemm_phase(const u16* A, const u16* Bt, int Mrows, int N, int K, const Epi& epi) {
  pg8::Gemm g{A, Bt, Mrows, N, K};
  pg8::StaticOrder S; S.init(Mrows, N, (int)gridDim.x, obid());
  pg8::gemm_phase<Epi, pg8::StaticOrder, false>((PG8_LAS unsigned char*)g_lds, g, S, epi, nullptr);
}

__device__ void phase_feat(const Params& p, int l) {
  const int tid = otid(), lane = tid & 63, wave = tid >> 6;
  const bool even = !(l & 1); const int e = l >> 1;
  const int NQ = even ? 8 : 16, NKV = even ? 2 : 4, ld = even ? EVC : ODC;
  const int nch = NQ + 2 * NKV;
  const u16* P = (const u16*)(p.ws + WS_ACT);
  u16* Q = (u16*)(p.ws + WS_Q); u16* Kd = (u16*)(p.ws + WS_K); u16* Vt = (u16*)(p.ws + WS_VT);
  u16* vts = (u16*)g_lds;
  const float* qg = p.in[10] + e * 64; const float* kg = p.in[11] + e * 64;
  const int i = lane & 31;
  const float invf = exp2f(-(float)(i & 15) * (13.287712379549449f / 16.f));
  for (int g = obid(); g < MTOT / 64; g += gridDim.x) {
    const int row0 = g * 64; const bool lat = row0 < MLAT;
    int b, tok0;
    if (lat) { b = row0 >> 12; tok0 = row0 & 4095; } else { int r = row0 - MLAT; b = r >> 8; tok0 = 4096 + (r & 255); }
    for (int ti = wave; ti < 64; ti += 8) {
      const int row = row0 + ti, tok = tok0 + ti;
      float cs = 1.f, sn = 0.f;
      if (lat) { float pos = (i < 16) ? (float)(tok >> 6) : (float)(tok & 63); float ang = pos * invf; cs = __cosf(ang); sn = __sinf(ang); }
      for (int c2 = 0; c2 < nch; c2 += 2) {
        const int ch = c2 + (lane >> 5);
        unsigned pv = *(const unsigned*)(P + (size_t)row * ld + ch * 64 + 2 * i);
        float x0 = bf2f((u16)(pv & 0xffff)), x1 = bf2f((u16)(pv >> 16));
        const bool isq = ch < NQ, isk = !isq && ch < NQ + NKV;
        if (even) {
          float ss = x0 * x0 + x1 * x1;
#pragma unroll
          for (int o = 16; o >= 1; o >>= 1) ss += __shfl_xor(ss, o);
          if (isq || isk) {
            float r = rsqrtf(ss * (1.f / 64.f) + 1e-6f);
            const float* gp = isq ? qg : kg;
            x0 *= r * gp[2 * i]; x1 *= r * gp[2 * i + 1];
          }
        }
        if (isq || isk) {
          float y0 = x0 * cs - x1 * sn, y1 = x0 * sn + x1 * cs;
          if (isq) {
            const float sc = 0.125f * 1.4426950408889634f;
            *(unsigned*)(Q + ((size_t)(b * NQ + ch) * NTOK + tok) * 64 + 2 * i) = pack2(y0 * sc, y1 * sc);
          } else {
            *(unsigned*)(Kd + ((size_t)(b * NKV + (ch - NQ)) * NTOK + tok) * 64 + 2 * i) = pack2(y0, y1);
          }
        } else {
          int vr = (ch - NQ - NKV) * 64 + 2 * i;
          vts[vr * 72 + ti] = f2bf(x0); vts[(vr + 1) * 72 + ti] = f2bf(x1);
        }
      }
    }
    __syncthreads();
    for (int idx = tid; idx < NKV * 64 * 8; idx += 512) {
      int r = idx >> 3, seg = idx & 7; int kvh = r >> 6, d = r & 63;
      uint4 val = *(const uint4*)&vts[r * 72 + seg * 8];
      *(uint4*)(Vt + ((size_t)(b * NKV + kvh) * 64 + d) * NTOK + tok0 + seg * 8) = val;
    }
    __syncthreads();
  }
}

DI bf16x8 pack8(const f32x16& x, int s) {
  bf16x8 r;
#pragma unroll
  for (int j = 0; j < 8; ++j) r[j] = (short)f2bf(x[8 * s + j]);
  return r;
}

__device__ void attn_item(const Params& p, int NQ, int NKV, int b, int kvh, int q0, bool windowed, bool has_sink, const float* sinkp) {
  const int tid = otid(), lane = tid & 63, wave = tid >> 6, r = lane & 31, h = lane >> 5;
  const u16* Q = (const u16*)(p.ws + WS_Q); const u16* Kd = (const u16*)(p.ws + WS_K); const u16* Vt = (const u16*)(p.ws + WS_VT);
  u16* O = (u16*)(p.ws + WS_H);
  const int head = kvh * 4 + (wave >> 1);
  const int qtok = q0 + (wave & 1) * 32 + r;
  const bool is_ctx = q0 >= 4096;
  const u16* qp = Q + ((size_t)(b * NQ + head) * NTOK + qtok) * 64;
  bf16x8 qf[4];
#pragma unroll
  for (int kk = 0; kk < 4; ++kk) qf[kk] = *(const bf16x8*)(qp + kk * 16 + h * 8);
  const u16* Kb = Kd + (size_t)(b * NKV + kvh) * NTOK * 64;
  const u16* Vb = Vt + (size_t)(b * NKV + kvh) * 64 * NTOK;
  int nt, nwin = 0, wlo = 0;
  if (is_ctx) { nt = 4; wlo = 4096; nwin = 0; }
  else if (windowed) { wlo = q0 - 128 < 128 ? 128 : q0 - 128; int whi = q0 + 192 > 4096 ? 4096 : q0 + 192; nwin = (whi - wlo) >> 6; nt = nwin + 4; }
  else { nt = 68; }
#define KSTART(it) (is_ctx ? 4096 + (it) * 64 : (windowed ? ((it) < nwin ? wlo + (it) * 64 : 4096 + ((it) - nwin) * 64) : (it) * 64))
  u16* Ks = (u16*)g_lds; u16* Vs = Ks + 2 * 64 * 72;
  const int lrow = tid >> 3, lseg = tid & 7;
  uint4 kreg, vreg;
  { int ks = KSTART(0);
    kreg = *(const uint4*)(Kb + (size_t)(ks + lrow) * 64 + lseg * 8);
    vreg = *(const uint4*)(Vb + (size_t)lrow * NTOK + ks + lseg * 8);
    *(uint4*)&Ks[lrow * 72 + lseg * 8] = kreg; *(uint4*)&Vs[lrow * 72 + lseg * 8] = vreg; }
  __syncthreads();
  f32x16 ot[2];
#pragma unroll
  for (int i = 0; i < 16; ++i) { ot[0][i] = 0.f; ot[1][i] = 0.f; }
  float mrun = -1e30f, lsum = 0.f;
  if (windowed && !is_ctx) { int nph = qtok + 129 - 4096; if (nph > 0) { mrun = 0.f; lsum = (float)nph; } }
  for (int it = 0; it < nt; ++it) {
    const int cur = it & 1;
    const u16* Kc = Ks + cur * 64 * 72; const u16* Vc = Vs + cur * 64 * 72;
    if (it + 1 < nt) { int ks = KSTART(it + 1);
      kreg = *(const uint4*)(Kb + (size_t)(ks + lrow) * 64 + lseg * 8);
      vreg = *(const uint4*)(Vb + (size_t)lrow * NTOK + ks + lseg * 8); }
    f32x16 st[2];
#pragma unroll
    for (int kt = 0; kt < 2; ++kt) {
#pragma unroll
      for (int i = 0; i < 16; ++i) st[kt][i] = 0.f;
#pragma unroll
      for (int kk = 0; kk < 4; ++kk) {
        bf16x8 kf = *(const bf16x8*)&Kc[(kt * 32 + r) * 72 + kk * 16 + h * 8];
        st[kt] = __builtin_amdgcn_mfma_f32_32x32x16_bf16(kf, qf[kk], st[kt], 0, 0, 0);
      }
    }
    if (windowed && it < nwin) {
      const int ks = KSTART(it);
#pragma unroll
      for (int kt = 0; kt < 2; ++kt)
#pragma unroll
        for (int i = 0; i < 16; ++i) {
          int key = ks + kt * 32 + (i & 3) + 8 * (i >> 2) + 4 * h;
          int dlt = key - qtok; dlt = dlt < 0 ? -dlt : dlt;
          if (dlt > 128) st[kt][i] = -1e30f;
        }
    }
    float mx = -1e30f;
#pragma unroll
    for (int kt = 0; kt < 2; ++kt)
#pragma unroll
      for (int i = 0; i < 16; ++i) mx = fmaxf(mx, st[kt][i]);
    mx = fmaxf(mx, __shfl_xor(mx, 32));
    const float mnew = fmaxf(mrun, mx);
    const float alpha = exp2f(mrun - mnew);
    float rs = 0.f;
#pragma unroll
    for (int kt = 0; kt < 2; ++kt)
#pragma unroll
      for (int i = 0; i < 16; ++i) {
        float sv = st[kt][i];
        float pe = sv <= -1e29f ? 0.f : exp2f(sv - mnew);
        st[kt][i] = pe; rs += pe;
      }
    rs += __shfl_xor(rs, 32);
    lsum = lsum * alpha + rs;
    mrun = mnew;
#pragma unroll
    for (int i = 0; i < 16; ++i) { ot[0][i] *= alpha; ot[1][i] *= alpha; }
#pragma unroll
    for (int kt = 0; kt < 2; ++kt)
#pragma unroll
      for (int s = 0; s < 2; ++s) {
        bf16x8 pf = pack8(st[kt], s);
#pragma unroll
        for (int db = 0; db < 2; ++db) {
          const u16* vp = &Vc[(db * 32 + r) * 72 + kt * 32 + 16 * s + 4 * h];
          uint2 v0 = *(const uint2*)vp, v1 = *(const uint2*)(vp + 8);
          uint4 vv = make_uint4(v0.x, v0.y, v1.x, v1.y);
          bf16x8 vf = __builtin_bit_cast(bf16x8, vv);
          ot[db] = __builtin_amdgcn_mfma_f32_32x32x16_bf16(vf, pf, ot[db], 0, 0, 0);
        }
      }
    if (it + 1 < nt) {
      u16* Kn = Ks + (cur ^ 1) * 64 * 72; u16* Vn = Vs + (cur ^ 1) * 64 * 72;
      *(uint4*)&Kn[lrow * 72 + lseg * 8] = kreg; *(uint4*)&Vn[lrow * 72 + lseg * 8] = vreg;
    }
    __syncthreads();
  }
#undef KSTART
  if (has_sink) lsum += exp2f(sinkp[head] * 1.4426950408889634f - mrun);
  const float inv = 1.f / lsum;
  const size_t orow = is_ctx ? (size_t)MLAT + b * 256 + (qtok - 4096) : (size_t)b * 4096 + qtok;
  u16* op = O + orow * D + head * 64;
#pragma unroll
  for (int db = 0; db < 2; ++db)
#pragma unroll
    for (int g = 0; g < 4; ++g) {
      uint2 o;
      o.x = pack2(ot[db][4 * g + 0] * inv, ot[db][4 * g + 1] * inv);
      o.y = pack2(ot[db][4 * g + 2] * inv, ot[db][4 * g + 3] * inv);
      *(uint2*)(op + db * 32 + 8 * g + 4 * h) = o;
    }
}

__device__ void scan_chain(const Params& p, int e, int chain) {
  const int tid = otid(), lane = tid & 63, wave = tid >> 6;
  const int b = chain >> 4, h = (chain >> 1) & 7, d = chain & 1;
  const u16* P = (const u16*)(p.ws + WS_ACT);
  u16* Y = (u16*)(p.ws + WS_Y);
  float* w2s = (float*)g_lds;
  float* a2s = w2s + 4096;
  float* sb = a2s + 4096;
  float* part = sb + 6144;
  float* raw = part + 1024;
  float* tk = raw + 5760;
  float* ttw = tk + 1024;
  float* tal = ttw + 1024;
  float* yp = raw;
  const float* mu = p.in[12] + (size_t)e * 2 * 1920;
  for (int i = tid; i < 4096; i += 512) {
    int r = i >> 6, c = i & 63;
    w2s[i] = p.in[14][((size_t)(e * 2 + d) * 64 + r) * 512 + h * 64 + c];
    a2s[i] = p.in[16][((size_t)(e * 2 + d) * 64 + r) * 512 + h * 64 + c];
  }
  const int hc = h * 64 + lane;
  const float kkc = p.in[18][e * 512 + hc], kac = p.in[19][e * 512 + hc];
  const float w0c = p.in[13][(e * 2 + d) * 512 + hc], a0c = p.in[15][(e * 2 + d) * 512 + hc];
  float S[8];
#pragma unroll
  for (int j = 0; j < 8; ++j) S[j] = 0.f;
  auto chunk_geo = [&](int ci, int& t0, int& T, size_t& rowbase) {
    if (ci < 16) { T = 256; rowbase = (size_t)MLAT + b * 256; t0 = d ? 240 - ci * 16 : ci * 16; }
    else { T = 4096; rowbase = (size_t)b * 4096; int cj = ci - 16; t0 = d ? 4080 - cj * 16 : cj * 16; }
  };
  uint2 pre[3];
  auto load_chunk = [&](int ci) {
    int t0, T; size_t rowbase; chunk_geo(ci, t0, T, rowbase);
#pragma unroll
    for (int k = 0; k < 3; ++k) {
      int idx = tid + k * 512; pre[k] = make_uint2(0u, 0u);
      if (idx < 1440) {
        int q = idx & 15, rest = idx >> 4; int seg = rest % 5, ri = rest / 5;
        int pos = t0 - 1 + ri;
        if (pos >= 0 && pos < T) {
          int colb = seg == 0 ? h * 64 : seg == 1 ? 512 + h * 64 : seg == 2 ? 1024 + h * 64 : seg == 3 ? 1536 + d * 64 : 1664 + d * 64;
          pre[k] = *(const uint2*)(P + (rowbase + pos) * EVC + RW + colb + q * 4);
        }
      }
    }
  };
  load_chunk(0);
  __syncthreads();
#pragma unroll 1
  for (int ci = 0; ci < 272; ++ci) {
    int t0, T; size_t rowbase; chunk_geo(ci, t0, T, rowbase);
#pragma unroll
    for (int k = 0; k < 3; ++k) {
      int idx = tid + k * 512;
      if (idx < 1440) {
        int q = idx & 15, rest = idx >> 4; int seg = rest % 5, ri = rest / 5;
        float* dst = raw + ri * 320 + seg * 64 + q * 4;
        dst[0] = bf2f((u16)(pre[k].x & 0xffff)); dst[1] = bf2f((u16)(pre[k].x >> 16));
        dst[2] = bf2f((u16)(pre[k].y & 0xffff)); dst[3] = bf2f((u16)(pre[k].y >> 16));
      }
    }
    if (ci + 1 < 272) load_chunk(ci + 1);
    __syncthreads();
#pragma unroll 1
    for (int idx = tid; idx < 5120; idx += 512) {
      int c = idx & 63, rest = idx >> 6; int seg = rest % 5, i = rest / 5;
      int pos = d ? t0 + 15 - i : t0 + i; int ri = pos - t0 + 1;
      int colb = seg == 0 ? h * 64 : seg == 1 ? 512 + h * 64 : seg == 2 ? 1024 + h * 64 : seg == 3 ? 1536 + d * 64 : 1664 + d * 64;
      float cur = raw[ri * 320 + seg * 64 + c], prv = raw[(ri - 1) * 320 + seg * 64 + c], nxt = raw[(ri + 1) * 320 + seg * 64 + c];
      float f = cur + mu[colb + c] * (prv - cur) + mu[1920 + colb + c] * (nxt - cur);
      if (seg == 0) sb[(i * 6 + 0) * 64 + c] = f;
      else if (seg == 1) tk[i * 64 + c] = f;
      else if (seg == 2) sb[(i * 6 + 3) * 64 + c] = f;
      else if (seg == 3) ttw[i * 64 + c] = tanhf(f);
      else tal[i * 64 + c] = f;
    }
    __syncthreads();
#pragma unroll 1
    for (int q = 0; q < 2; ++q) {
      const int i = wave * 2 + q;
      float kv = tk[i * 64 + lane];
      float kn = kv * kkc;
      float ss = wave_sum(kn * kn);
      float kk = kn * rsqrtf(ss + 1e-6f);
      float wl = w0c, al = a0c;
#pragma unroll 4
      for (int rr = 0; rr < 64; ++rr) { wl += ttw[i * 64 + rr] * w2s[rr * 64 + lane]; al += tal[i * 64 + rr] * a2s[rr * 64 + lane]; }
      float xx = -wl;
      float sp = fmaxf(xx, 0.f) + log1pf(__expf(-fabsf(xx)));
      float ee = __expf(-sp - 0.5f);
      float wd = __expf(-ee);
      float a = 1.f / (1.f + __expf(-al));
      sb[(i * 6 + 1) * 64 + lane] = wd;
      sb[(i * 6 + 2) * 64 + lane] = kv * (1.f + (a - 1.f) * kac);
      sb[(i * 6 + 4) * 64 + lane] = kk;
      sb[(i * 6 + 5) * 64 + lane] = kk * a;
    }
    __syncthreads();
#pragma unroll 1
    for (int s = 0; s < 16; ++s) {
      const float* sbs = sb + s * 384 + wave * 8;
      float4 r0 = *(const float4*)(sbs + 0 * 64), r1 = *(const float4*)(sbs + 0 * 64 + 4);
      float4 w0 = *(const float4*)(sbs + 1 * 64), w1 = *(const float4*)(sbs + 1 * 64 + 4);
      float4 k0 = *(const float4*)(sbs + 2 * 64), k1 = *(const float4*)(sbs + 2 * 64 + 4);
      float4 q0 = *(const float4*)(sbs + 4 * 64), q1 = *(const float4*)(sbs + 4 * 64 + 4);
      float4 b0 = *(const float4*)(sbs + 5 * 64), b1 = *(const float4*)(sbs + 5 * 64 + 4);
      float vi = sb[s * 384 + 3 * 64 + lane];
      float pa = (S[0] * q0.x + S[1] * q0.y) + (S[2] * q0.z + S[3] * q0.w) + (S[4] * q1.x + S[5] * q1.y) + (S[6] * q1.z + S[7] * q1.w);
      float* pp = part + (s & 1) * 512;
      pp[wave * 64 + lane] = pa;
      __syncthreads();
      float sa = 0.f;
#pragma unroll
      for (int w = 0; w < 8; ++w) sa += pp[w * 64 + lane];
      S[0] = S[0] * w0.x - sa * b0.x + vi * k0.x; S[1] = S[1] * w0.y - sa * b0.y + vi * k0.y;
      S[2] = S[2] * w0.z - sa * b0.z + vi * k0.z; S[3] = S[3] * w0.w - sa * b0.w + vi * k0.w;
      S[4] = S[4] * w1.x - sa * b1.x + vi * k1.x; S[5] = S[5] * w1.y - sa * b1.y + vi * k1.y;
      S[6] = S[6] * w1.z - sa * b1.z + vi * k1.z; S[7] = S[7] * w1.w - sa * b1.w + vi * k1.w;
      float yv = (S[0] * r0.x + S[1] * r0.y) + (S[2] * r0.z + S[3] * r0.w) + (S[4] * r1.x + S[5] * r1.y) + (S[6] * r1.z + S[7] * r1.w);
      yp[(s * 8 + wave) * 64 + lane] = yv;
    }
    __syncthreads();
#pragma unroll
    for (int k = 0; k < 2; ++k) {
      int s = wave + 8 * k; float yv = 0.f;
#pragma unroll
      for (int w = 0; w < 8; ++w) yv += yp[(s * 8 + w) * 64 + lane];
      int pos = d ? t0 + 15 - s : t0 + s;
      Y[((rowbase + pos) * 2 + d) * 512 + h * 64 + lane] = f2bf(yv);
    }
    __syncthreads();
  }
}

__device__ void phase_mix(const Params& p, int l) {
  const bool even = !(l & 1); const int e = l >> 1;
  if (even) { for (int ch = obid(); ch < 128; ch += gridDim.x) scan_chain(p, e, ch); }
  const int NQ = even ? 8 : 16, NKV = even ? 2 : 4;
  const int nlat = 8 * NKV * 64, nctx = (l == 3) ? 0 : 8 * NKV * 4;
  unsigned* cnt = (unsigned*)(p.ws + WS_CNT) + l;
  volatile int* slot = (volatile int*)(g_lds + 40960);
  const float* sinkp = even ? nullptr : p.in[25] + e * 16;
  for (;;) {
    __syncthreads();
    if (otid() == 0) *slot = (int)atomicAdd(cnt, 1u);
    __syncthreads();
    int item = *slot;
    if (item >= nlat + nctx) break;
    int b, kvh, q0;
    if (item < nlat) { int qt = item & 63; int r = item >> 6; kvh = r % NKV; b = r / NKV; q0 = qt * 64; }
    else { int it2 = item - nlat; int qt = it2 & 3; int r = it2 >> 2; kvh = r % NKV; b = r / NKV; q0 = 4096 + qt * 64; }
    attn_item(p, NQ, NKV, b, kvh, q0, !even, !even, sinkp);
  }
}

__device__ void phase_readout(const Params& p, int e) {
  const int tid = otid(), lane = tid & 63;
  const u16* P = (const u16*)(p.ws + WS_ACT);
  const u16* Y = (const u16*)(p.ws + WS_Y);
  u16* O = (u16*)(p.ws + WS_H);
  float* sg = (float*)g_lds;
  const float* mu = p.in[12] + (size_t)e * 2 * 1920;
  const float* g2 = p.in[17] + (size_t)e * 128 * 512;
  const int c = tid;
  const float gnw = p.in[21][e * 512 + c], gnb = p.in[22][e * 512 + c], rkc = p.in[20][e * 512 + c];
  const float mr0 = mu[c], mr1 = mu[1920 + c], mk0 = mu[512 + c], mk1 = mu[1920 + 512 + c], mv0 = mu[1024 + c], mv1 = mu[1920 + 1024 + c];
  for (int tile = obid(); tile < MTOT / 32; tile += gridDim.x) {
    const int row0 = tile * 32; const bool lat = row0 < MLAT;
    const int T = lat ? 4096 : 256; const int pos0 = lat ? (row0 & 4095) : ((row0 - MLAT) & 255);
    for (int idx = tid; idx < 4096; idx += 512) {
      int ti = idx >> 7, rr = idx & 127; int col = RW + 1792 + rr; int row = row0 + ti, pos = pos0 + ti;
      float cur = bf2f(P[(size_t)row * EVC + col]);
      float prv = pos > 0 ? bf2f(P[(size_t)(row - 1) * EVC + col]) : 0.f;
      float nxt = pos < T - 1 ? bf2f(P[(size_t)(row + 1) * EVC + col]) : 0.f;
      float f = cur + mu[1792 + rr] * (prv - cur) + mu[1920 + 1792 + rr] * (nxt - cur);
      sg[rr * 32 + ti] = 1.f / (1.f + __expf(-f));
    }
    __syncthreads();
    float acc[32];
#pragma unroll
    for (int t = 0; t < 32; ++t) acc[t] = 0.f;
    for (int rr = 0; rr < 128; ++rr) {
      float gw = g2[rr * 512 + c];
#pragma unroll
      for (int q = 0; q < 8; ++q) {
        float4 s4 = *(const float4*)&sg[rr * 32 + q * 4];
        acc[q * 4 + 0] += gw * s4.x; acc[q * 4 + 1] += gw * s4.y; acc[q * 4 + 2] += gw * s4.z; acc[q * 4 + 3] += gw * s4.w;
      }
    }
#pragma unroll
    for (int ti = 0; ti < 32; ++ti) {
      const int row = row0 + ti, pos = pos0 + ti;
      float y = bf2f(Y[((size_t)row * 2 + 0) * 512 + c]) + bf2f(Y[((size_t)row * 2 + 1) * 512 + c]);
      float mean = wave_sum(y) * (1.f / 64.f);
      float dv = y - mean;
      float var = wave_sum(dv * dv) * (1.f / 64.f);
      float yn = dv * rsqrtf(var + 64e-5f) * gnw + gnb;
      const u16* pr = P + (size_t)row * EVC + RW + c;
      const bool hp = pos > 0, hn = pos < T - 1;
      float rc = bf2f(pr[0]), kc = bf2f(pr[512]), vc = bf2f(pr[1024]);
      float rp = hp ? bf2f(pr[-EVC]) : 0.f, kp = hp ? bf2f(pr[512 - EVC]) : 0.f, vp = hp ? bf2f(pr[1024 - EVC]) : 0.f;
      float rn = hn ? bf2f(pr[EVC]) : 0.f, kn = hn ? bf2f(pr[512 + EVC]) : 0.f, vn = hn ? bf2f(pr[1024 + EVC]) : 0.f;
      float rs = rc + mr0 * (rp - rc) + mr1 * (rn - rc);
      float ks = kc + mk0 * (kp - kc) + mk1 * (kn - kc);
      float vs = vc + mv0 * (vp - vc) + mv1 * (vn - vc);
      float bonus = wave_sum(rs * ks * rkc) * vs;
      O[(size_t)row * D + 512 + c] = f2bf((yn + bonus) * acc[ti]);
    }
    __syncthreads();
  }
  (void)lane;
}

__device__ void phase_final(const Params& p) {
  const int tid_ = otid(); const int lane = tid_ & 63, wave = tid_ >> 6;
  const float* fg = p.in[26];
  for (int row = obid() * 8 + wave; row < MLAT; row += gridDim.x * 8) {
    float4* xr = (float4*)(p.out + (size_t)row * D);
    float4 v[4]; float ss = 0.f;
#pragma unroll
    for (int q = 0; q < 4; ++q) { v[q] = xr[lane + q * 64]; ss += v[q].x * v[q].x + v[q].y * v[q].y + v[q].z * v[q].z + v[q].w * v[q].w; }
    ss = wave_sum(ss);
    float rstd = rsqrtf(ss * (1.f / 1024.f) + 1e-6f);
#pragma unroll
    for (int q = 0; q < 4; ++q) {
      float4 g = *(const float4*)(fg + (lane + q * 64) * 4);
      xr[lane + q * 64] = make_float4(v[q].x * rstd * g.x, v[q].y * rstd * g.y, v[q].z * rstd * g.z, v[q].w * rstd * g.w);
    }
  }
}

__device__ void run_phase(const Params& p, int ph) {
  if (ph == 0) { phase_setup(p); return; }
  if (ph == 1) { phase_mod(p); return; }
  if (ph == 50) { phase_final(p); return; }
  const int l = (ph - 2) / 12, s = (ph - 2) % 12;
  const bool even = !(l & 1); const int e = l >> 1;
  const int mrows_late = (l == 3) ? MLAT : MTOT;
  const float* modl = (const float*)(p.ws + WS_MOD) + (size_t)l * 9 * 9216;
  const u16* H = (const u16*)(p.ws + WS_H);
  u16* ACT = (u16*)(p.ws + WS_ACT);
  float* xctx = (float*)(p.ws + WS_XCTX);
  switch (s) {
    case 0: phase_prep(p, l, 0, MTOT); break;
    case 1: { EpiAct ep{ACT}; gemm_phase(H, (const u16*)(p.ws + WS_FFI) + (size_t)(l * 2 + 0) * 5632 * 1024, MTOT, 5632, 1024, ep); } break;
    case 2: { EpiRes ep{p.out, xctx, modl, 2, 0.5f}; gemm_phase(ACT, (const u16*)(p.ws + WS_FFO) + (size_t)(l * 2 + 0) * 1024 * 2816, MTOT, 1024, 2816, ep); } break;
    case 3: phase_prep(p, l, 3, MTOT); break;
    case 4:
      if (even) { EpiP ep{ACT, EVC, EVC}; gemm_phase(H, (const u16*)(p.ws + WS_EVI) + (size_t)e * EVCP * 1024, MTOT, EVCP, 1024, ep); }
      else { EpiP ep{ACT, ODC, ODC}; gemm_phase(H, (const u16*)(p.ws + WS_ODI) + (size_t)e * ODC * 1024, MTOT, ODC, 1024, ep); }
      break;
    case 5: phase_feat(p, l); break;
    case 6: phase_mix(p, l); break;
    case 7: if (even) phase_readout(p, e); break;
    case 8: { EpiRes ep{p.out, xctx, modl, 5, 1.0f};
      gemm_phase(H, (const u16*)(p.ws + (even ? WS_EVO : WS_ODO)) + (size_t)e * 1024 * 1024, mrows_late, 1024, 1024, ep); } break;
    case 9: phase_prep(p, l, 6, mrows_late); break;
    case 10: { EpiAct ep{ACT}; gemm_phase(H, (const u16*)(p.ws + WS_FFI) + (size_t)(l * 2 + 1) * 5632 * 1024, mrows_late, 5632, 1024, ep); } break;
    case 11: { EpiRes ep{p.out, xctx, modl, 8, 0.5f}; gemm_phase(ACT, (const u16*)(p.ws + WS_FFO) + (size_t)(l * 2 + 1) * 1024 * 2816, mrows_late, 1024, 2816, ep); } break;
  }
}

__global__ void __launch_bounds__(512, 2) mega(Params p, int ph_lo, int ph_hi) {
  cg::grid_group grid = cg::this_grid();
  for (int ph = ph_lo; ph < ph_hi; ++ph) {
    run_phase(p, ph);
    if (ph + 1 < ph_hi) grid.sync();
  }
}

extern "C" void kernel_launch(void* const* d_in, const int* in_sizes, int n_in, void* d_out, int out_size, void* d_ws, size_t ws_size,
                              hipStream_t stream) {
  static int grid = 0;
  if (grid == 0) {
    if (ws_size < WS_END) { fprintf(stderr, "kernel_launch: workspace too small: %zu < %zu\n", ws_size, (size_t)WS_END); grid = -1; return; }
    hipFuncSetAttribute((const void*)mega, hipFuncAttributeMaxDynamicSharedMemorySize, LDS_BYTES);
    int dev = 0, cus = 0, per_cu = 0;
    hipGetDevice(&dev);
    hipDeviceGetAttribute(&cus, hipDeviceAttributeMultiprocessorCount, dev);
    hipOccupancyMaxActiveBlocksPerMultiprocessor(&per_cu, (const void*)mega, 512, LDS_BYTES);
    if (per_cu < 1) per_cu = 1;
    grid = cus * 1;
    (void)hipGetLastError();
  }
  if (grid < 0) return;
  Params p{};
  for (int i = 0; i < 27; ++i) p.in[i] = (const float*)d_in[i];
  p.out = (float*)d_out; p.ws = (unsigned char*)d_ws;
#if MEGA
  int lo = 0, hi = NPH;
  void* args[] = {&p, &lo, &hi};
  hipError_t e = hipLaunchCooperativeKernel((const void*)mega, dim3(grid), dim3(512), args, LDS_BYTES, stream);
  if (e != hipSuccess) fprintf(stderr, "cooperative launch failed: %s\n", hipGetErrorString(e));
#else
  for (int ph = 0; ph < NPH; ++ph) {
    if (ph >= 2 && ph < 50) { int l = (ph - 2) / 12, s = (ph - 2) % 12; if (s == 7 && (l & 1)) continue; }
    hipLaunchKernelGGL(mega, dim3(grid), dim3(512), LDS_BYTES, stream, p, ph, ph + 1);
  }
#endif
}
```

```cpp
#include <hip/hip_runtime.h>
#include <hip/hip_cooperative_groups.h>
#include <cstdio>
namespace cg = cooperative_groups;

#ifndef MEGA
#define MEGA 1
#endif
#ifndef DUP
#define DUP 0
#endif
#ifndef DUPSKIP
#define DUPSKIP 0
#endif
#ifndef SCANMODE
#define SCANMODE 0
#endif

typedef unsigned short u16;
using bf16x8 = __attribute__((ext_vector_type(8))) short;
using f32x4  = __attribute__((ext_vector_type(4))) float;
using f32x16 = __attribute__((ext_vector_type(16))) float;
#define DI __device__ __forceinline__

constexpr int D = 1024, MLAT = 32768, MCTX = 2048, MTOT = 34816, NTOK = 4352;
constexpr int DFF = 2816, EVC = 2688, EVCP = 2816, ODC = 1536, RW = 768;
constexpr int NPH = 51;
constexpr int LDS_BYTES = 131072 + 64;

constexpr size_t WS_FFI = 0;
constexpr size_t WS_FFO = WS_FFI + (size_t)8 * 5632 * 1024 * 2;
constexpr size_t WS_EVI = WS_FFO + (size_t)8 * 1024 * 2816 * 2;
constexpr size_t WS_EVO = WS_EVI + (size_t)2 * 2816 * 1024 * 2;
constexpr size_t WS_ODI = WS_EVO + (size_t)2 * 1024 * 1024 * 2;
constexpr size_t WS_ODO = WS_ODI + (size_t)2 * 1536 * 1024 * 2;
constexpr size_t WS_MOD = WS_ODO + (size_t)2 * 1024 * 1024 * 2;
constexpr size_t WS_XCTX = WS_MOD + (size_t)4 * 9 * 9216 * 4;
constexpr size_t WS_H = WS_XCTX + (size_t)MCTX * D * 4;
constexpr size_t WS_ACT = WS_H + (size_t)MTOT * D * 2;
constexpr size_t WS_Q = WS_ACT + (size_t)MTOT * DFF * 2;
constexpr size_t WS_K = WS_Q + (size_t)8 * 16 * NTOK * 64 * 2;
constexpr size_t WS_VT = WS_K + (size_t)8 * 4 * NTOK * 64 * 2;
constexpr size_t WS_Y = WS_VT + (size_t)8 * 4 * NTOK * 64 * 2;
constexpr size_t WS_CNT = WS_Y + (size_t)MTOT * 2 * 512 * 2;
constexpr size_t WS_BAR = WS_CNT + 256;
constexpr size_t WS_END = WS_BAR + 16384;

struct Params {
  const float* in[27];
  float* out;
  unsigned char* ws;
};

extern __shared__ __attribute__((aligned(16))) unsigned char g_lds[];

DI int otid() { int t = threadIdx.x; asm volatile("" : "+v"(t)); return t; }
DI int obid() { int b = blockIdx.x; asm volatile("" : "+s"(b)); return b; }
DI u16 f2bf(float f) { unsigned u = __float_as_uint(f); u += 0x7fffu + ((u >> 16) & 1u); return (u16)(u >> 16); }
DI float bf2f(u16 h) { return __uint_as_float(((unsigned)h) << 16); }
DI unsigned pack2(float a, float b) { unsigned r; asm("v_cvt_pk_bf16_f32 %0, %1, %2" : "=v"(r) : "v"(a), "v"(b)); return r; }
template <int CTRL, int RMASK> DI float dpp_add(float v) {
  return v + __int_as_float(__builtin_amdgcn_update_dpp(0, __float_as_int(v), CTRL, RMASK, 0xF, RMASK == 0xF));
}
DI float row_sum16(float v) {
  v = dpp_add<0xB1, 0xF>(v); v = dpp_add<0x4E, 0xF>(v); v = dpp_add<0x141, 0xF>(v); v = dpp_add<0x140, 0xF>(v);
  return v;
}
DI float wave_sum(float v) {
  v = row_sum16(v);
  v = dpp_add<0x142, 0xA>(v); v = dpp_add<0x143, 0xC>(v);
  return __int_as_float(__builtin_amdgcn_readlane(__float_as_int(v), 63));
}
DI float* xrow(const Params& p, int row) {
  return row < MLAT ? p.out + (size_t)row * D : (float*)(p.ws + WS_XCTX) + (size_t)(row - MLAT) * D;
}

DI void convert_tile(const float* src, int ld_src, u16* dst, int ld_dst, int k0, int nsrc0, int ndst0) {
  float* t = (float*)g_lds;
  const int tid = otid();
#pragma unroll
  for (int it = 0; it < 2; ++it) {
    int idx = tid + it * 512; int i = idx >> 4, j4 = idx & 15;
    float4 v = *(const float4*)(src + (size_t)(k0 + i) * ld_src + nsrc0 + j4 * 4);
    t[(j4 * 4 + 0) * 65 + i] = v.x; t[(j4 * 4 + 1) * 65 + i] = v.y; t[(j4 * 4 + 2) * 65 + i] = v.z; t[(j4 * 4 + 3) * 65 + i] = v.w;
  }
  __syncthreads();
  int n = tid >> 3, kq = tid & 7;
  const float* r = t + n * 65 + kq * 8;
  uint4 o; o.x = pack2(r[0], r[1]); o.y = pack2(r[2], r[3]); o.z = pack2(r[4], r[5]); o.w = pack2(r[6], r[7]);
  *(uint4*)(dst + (size_t)(ndst0 + n) * ld_dst + k0 + kq * 8) = o;
  __syncthreads();
}

__device__ void phase_setup(const Params& p) {
  const int tid = otid();
  const int N_FFI = 8 * 16 * 88, N_FFO = 8 * 44 * 16, N_EVI = 2 * 16 * 42, N_EVO = 2 * 256, N_ODI = 2 * 16 * 24, N_ODO = 2 * 256;
  const int total = N_FFI + N_FFO + N_EVI + N_EVO + N_ODI + N_ODO;
  for (int it = obid(); it < total; it += gridDim.x) {
    int t = it;
    if (t < N_FFI) {
      int m = t / 1408, r = t % 1408; int kt = r & 15, nt = r >> 4;
      int nd = nt * 64; int t256 = nd >> 8, half = (nd >> 7) & 1, c0 = nd & 127;
      convert_tile(p.in[6] + (size_t)m * 1024 * 5632, 5632, (u16*)(p.ws + WS_FFI) + (size_t)m * 5632 * 1024, 1024, kt * 64, half * 2816 + t256 * 128 + c0, nd);
      continue;
    }
    t -= N_FFI;
    if (t < N_FFO) {
      int m = t / 704, r = t % 704; int kt = r % 44, nt = r / 44;
      convert_tile(p.in[7] + (size_t)m * 2816 * 1024, 1024, (u16*)(p.ws + WS_FFO) + (size_t)m * 1024 * 2816, 2816, kt * 64, nt * 64, nt * 64);
      continue;
    }
    t -= N_FFO;
    if (t < N_EVI) {
      int m = t / 672, r = t % 672; int kt = r & 15, nt = r >> 4;
      convert_tile(p.in[8] + (size_t)m * 1024 * EVC, EVC, (u16*)(p.ws + WS_EVI) + (size_t)m * EVCP * 1024, 1024, kt * 64, nt * 64, nt * 64);
      continue;
    }
    t -= N_EVI;
    if (t < N_EVO) {
      int m = t / 256, r = t % 256; int kt = r & 15, nt = r >> 4;
      convert_tile(p.in[9] + (size_t)m * 1024 * 1024, 1024, (u16*)(p.ws + WS_EVO) + (size_t)m * 1024 * 1024, 1024, kt * 64, nt * 64, nt * 64);
      continue;
    }
    t -= N_EVO;
    if (t < N_ODI) {
      int m = t / 384, r = t % 384; int kt = r & 15, nt = r >> 4;
      convert_tile(p.in[23] + (size_t)m * 1024 * ODC, ODC, (u16*)(p.ws + WS_ODI) + (size_t)m * ODC * 1024, 1024, kt * 64, nt * 64, nt * 64);
      continue;
    }
    t -= N_ODI;
    {
      int m = t / 256, r = t % 256; int kt = r & 15, nt = r >> 4;
      convert_tile(p.in[24] + (size_t)m * 1024 * 1024, 1024, (u16*)(p.ws + WS_ODO) + (size_t)m * 1024 * 1024, 1024, kt * 64, nt * 64, nt * 64);
    }
  }
  for (int i = obid() * 512 + tid; i < 2 * 128 * 1024 / 8; i += gridDim.x * 512) {
    int m = i / (128 * 128), r = i % (128 * 128);
    *(uint4*)((u16*)(p.ws + WS_EVI) + (size_t)m * EVCP * 1024 + (size_t)EVC * 1024 + (size_t)r * 8) = make_uint4(0, 0, 0, 0);
  }
  {
    const float4* xs = (const float4*)p.in[0]; float4* xd = (float4*)p.out;
    for (size_t i = (size_t)obid() * 512 + tid; i < (size_t)MLAT * D / 4; i += (size_t)gridDim.x * 512) xd[i] = xs[i];
    const float4* cs = (const float4*)p.in[2]; float4* cd = (float4*)(p.ws + WS_XCTX);
    for (size_t i = (size_t)obid() * 512 + tid; i < (size_t)MCTX * D / 4; i += (size_t)gridDim.x * 512) cd[i] = cs[i];
  }
  if (obid() == 0 && tid < 64) ((unsigned*)(p.ws + WS_CNT))[tid] = 0u;
}

__device__ void phase_mod(const Params& p) {
  const int tid = otid();
  float* sc = (float*)g_lds;
  float* red = sc + 9 * 1024;
  for (int i = tid; i < 9 * 1024; i += 512) {
    int e = i >> 10, k = i & 1023; float v = e < 8 ? p.in[1][e * 1024 + k] : p.in[3][k];
    sc[i] = v / (1.f + __expf(-v));
  }
  __syncthreads();
  float* mod = (float*)(p.ws + WS_MOD);
  for (int tile = obid(); tile < 576; tile += gridDim.x) {
    int l = tile / 144, cgp = tile % 144;
    int cl = tid & 63, kg = tid >> 6;
    const float* w = p.in[4] + (size_t)l * 1024 * 9216 + cgp * 64 + cl;
    float acc[9];
#pragma unroll
    for (int e = 0; e < 9; ++e) acc[e] = 0.f;
    for (int k = kg * 128; k < kg * 128 + 128; ++k) {
      float wv = w[(size_t)k * 9216];
#pragma unroll
      for (int e = 0; e < 9; ++e) acc[e] += sc[e * 1024 + k] * wv;
    }
#pragma unroll
    for (int e = 0; e < 9; ++e) red[(kg * 9 + e) * 64 + cl] = acc[e];
    __syncthreads();
    for (int o = tid; o < 576; o += 512) {
      int e = o >> 6, cc = o & 63; float s = 0.f;
#pragma unroll
      for (int k2 = 0; k2 < 8; ++k2) s += red[(k2 * 9 + e) * 64 + cc];
      mod[(size_t)(l * 9 + e) * 9216 + cgp * 64 + cc] = s + p.in[5][l * 9216 + cgp * 64 + cc];
    }
    __syncthreads();
  }
}

__device__ void phase_prep(const Params& p, int l, int sh, int nrows) {
  const int tid_ = otid(); const int lane = tid_ & 63, wave = tid_ >> 6;
  u16* H = (u16*)(p.ws + WS_H);
  const float* modl = (const float*)(p.ws + WS_MOD) + (size_t)l * 9 * 9216;
  for (int row = obid() * 16 + wave; row < nrows; row += gridDim.x * 16) {
    const float4* xr0 = (const float4*)xrow(p, row);
    const float4* xr1 = (const float4*)xrow(p, row + 8);
    int e = row < MLAT ? row >> 12 : 8;
    const float* m = modl + (size_t)e * 9216;
    float4 v[2][4]; float ss0 = 0.f, ss1 = 0.f;
#pragma unroll
    for (int q = 0; q < 4; ++q) { v[0][q] = xr0[lane + q * 64]; v[1][q] = xr1[lane + q * 64]; }
#pragma unroll
    for (int q = 0; q < 4; ++q) {
      ss0 += v[0][q].x * v[0][q].x + v[0][q].y * v[0][q].y + v[0][q].z * v[0][q].z + v[0][q].w * v[0][q].w;
      ss1 += v[1][q].x * v[1][q].x + v[1][q].y * v[1][q].y + v[1][q].z * v[1][q].z + v[1][q].w * v[1][q].w;
    }
    ss0 = wave_sum(ss0); ss1 = wave_sum(ss1);
    const float rstd0 = rsqrtf(ss0 * (1.f / 1024.f) + 1e-6f), rstd1 = rsqrtf(ss1 * (1.f / 1024.f) + 1e-6f);
#pragma unroll
    for (int q = 0; q < 4; ++q) {
      int col = (lane + q * 64) * 4;
      float4 s4 = *(const float4*)(m + sh * 1024 + col), c4 = *(const float4*)(m + (sh + 1) * 1024 + col);
      uint2 o;
      o.x = pack2(v[0][q].x * rstd0 * (1.f + c4.x) + s4.x, v[0][q].y * rstd0 * (1.f + c4.y) + s4.y);
      o.y = pack2(v[0][q].z * rstd0 * (1.f + c4.z) + s4.z, v[0][q].w * rstd0 * (1.f + c4.w) + s4.w);
      *(uint2*)(H + (size_t)row * D + col) = o;
      o.x = pack2(v[1][q].x * rstd1 * (1.f + c4.x) + s4.x, v[1][q].y * rstd1 * (1.f + c4.y) + s4.y);
      o.y = pack2(v[1][q].z * rstd1 * (1.f + c4.z) + s4.z, v[1][q].w * rstd1 * (1.f + c4.w) + s4.w);
      *(uint2*)(H + (size_t)(row + 8) * D + col) = o;
    }
  }
}

namespace pg8 {
#define PG8_LAS __attribute__((address_space(3)))
typedef unsigned short bf16_t;
typedef unsigned u32x4 __attribute__((ext_vector_type(4)));
constexpr int BM = 256, BK = 64, HALF = 128, HTB = HALF * BK * 2, STAGE_BYTES = 8 * HTB, NXCD = 8, WGM = 8;
__host__ __device__ __forceinline__ int lds_byte(int r, int c) { const int st = (r >> 4) * 2 + (c >> 5), rr = r & 15, cc = c & 31, ob = rr * 64 + cc * 2; return st * 1024 + (ob ^ (((ob >> 9) & 1) << 5)); }
__host__ __device__ __forceinline__ void stage_rc(int b, int& R, int& C) { const int st = b / 1024, sb = b % 1024, swz = sb ^ (((sb >> 9) & 1) << 5); R = (st >> 1) * 16 + swz / 64; C = (st & 1) * 32 + (swz % 64) / 2; }
__host__ __device__ __forceinline__ int perm32(int rho) { const int n = rho >> 4, i = rho & 15; return 8 * (i >> 2) + 4 * n + (i & 3); }
struct Unit { int pm, pn; };
struct Gemm { const bf16_t* A; const bf16_t* Bt; int M, N, K; };
struct StaticOrder {
    int nM, nN, nwg, G, c;
    __host__ __device__ void init(int M, int N, int G_, int c_) { nM = M / BM; nN = N / BM; nwg = nM * nN; G = G_; c = c_; }
    __host__ __device__ bool next(int i, Unit& u) const {
        const long L = (long)i * G + c; if (L >= nwg) return false;
        int wgid = (int)L; { const int q = nwg / NXCD, r = nwg % NXCD, xcd = wgid % NXCD, off = wgid / NXCD; wgid = (xcd < r ? xcd * (q + 1) : r * (q + 1) + (xcd - r) * q) + off; }
        const int nig = WGM * nN, gid = wgid / nig, fm = gid * WGM, gsz = (nM - fm) < WGM ? (nM - fm) : WGM;
        u.pm = fm + ((wgid % nig) % gsz); u.pn = (wgid % nig) / gsz; return true;
    }
    __device__ __forceinline__ void a_ready(const Unit&) const {}
    __device__ __forceinline__ void done(const Unit&) const {}
};
template <class Epi, class Sched, bool STAMP = false>
__device__ __forceinline__ void gemm_phase(PG8_LAS unsigned char* lds, const Gemm g, const Sched& S, const Epi& E, unsigned long long* stamps) {
    const int tid = otid(), wid = __builtin_amdgcn_readfirstlane(tid >> 6), lane = tid & 63, wr = wid >> 2, wc = wid & 3, fr = lane & 15, fq = lane >> 4;
    const int K = g.K, nt = K / BK;
    int ts_lo = 0, ts_hi = 0, nts = 0; const unsigned long long rt_entry = STAMP ? (unsigned long long)wall_clock64() : 0ull;
#define PG8_STAMP() do { if (STAMP && wid == 0 && nts < 64) { const unsigned long long _c = (unsigned long long)clock64(); \
        ts_lo = (lane == nts) ? (int)(unsigned)_c : ts_lo; ts_hi = (lane == nts) ? (int)(unsigned)(_c >> 32) : ts_hi; ++nts; } } while (0)
    PG8_STAMP();
    unsigned voffA[2], voffB[2];
#pragma unroll
    for (int i = 0; i < 2; ++i) { int R, C; stage_rc(tid * 16 + i * 8192, R, C); const int Rb = Epi::PERM ? ((R & ~31) + perm32(R & 31)) : R;
        voffA[i] = (unsigned)(R * K + C) * 2u; voffB[i] = (unsigned)(Rb * K + C) * 2u; }
    const size_t kstep = (size_t)(BK * 2);
    const size_t hstep = (size_t)HALF * K * 2;
    const size_t tstep = 2 * hstep;
    const unsigned ldsw = (unsigned)wid * 1024u;
    const int aoff = lds_byte(wr * 64 + fr, fq * 8), boff = lds_byte(wc * 32 + fr, fq * 8);
#define PG8_SA(b, h) (((b) * 2 + (h)) * HTB)
#define PG8_SB(b, h) ((4 + (b) * 2 + (h)) * HTB)
#define PG8_STAGE(bufoff, gbase, voff) do { _Pragma("unroll") for (int _i = 0; _i < 2; ++_i) \
        __builtin_amdgcn_global_load_lds((const unsigned*)((const char*)(gbase) + (voff)[_i]), (PG8_LAS unsigned*)(lds + (bufoff) + ldsw + _i * 8192), 16, 0, 0); } while (0)
#define PG8_LDA(dst, b, h) do { _Pragma("unroll") for (int m = 0; m < 4; ++m) _Pragma("unroll") for (int k = 0; k < 2; ++k) dst[m][k] = *(const PG8_LAS bf16x8*)(lds + PG8_SA(b, h) + aoff + m * 2048 + k * 1024); } while (0)
#define PG8_LDB(dst, b, h) do { _Pragma("unroll") for (int n = 0; n < 2; ++n) _Pragma("unroll") for (int k = 0; k < 2; ++k) dst[n][k] = *(const PG8_LAS bf16x8*)(lds + PG8_SB(b, h) + boff + n * 2048 + k * 1024); } while (0)
#define PG8_MMA(ai, bj, At, Bt) do { __builtin_amdgcn_s_setprio(1); _Pragma("unroll") for (int m = 0; m < 4; ++m) _Pragma("unroll") for (int n = 0; n < 2; ++n) _Pragma("unroll") for (int k = 0; k < 2; ++k) \
        acc[ai][bj][m][n] = __builtin_amdgcn_mfma_f32_16x16x32_bf16(Bt[n][k], At[m][k], acc[ai][bj][m][n], 0, 0, 0); __builtin_amdgcn_s_setprio(0); } while (0)
#define PG8_WAIT_V(n) asm volatile("s_waitcnt vmcnt(" #n ")" ::: "memory")
#define PG8_WAIT_L(n) asm volatile("s_waitcnt lgkmcnt(" #n ")" ::: "memory")
#define PG8_BAR __builtin_amdgcn_s_barrier()
#define PG8_SCHED __builtin_amdgcn_sched_barrier(0)
    Unit cur, nxt; int ui = 0;
    if (!S.next(0, cur)) return;
    f32x4 acc[2][2][4][2];
#pragma unroll
    for (int a = 0; a < 2; ++a)
#pragma unroll
        for (int b = 0; b < 2; ++b)
#pragma unroll
            for (int m = 0; m < 4; ++m)
#pragma unroll
                for (int n = 0; n < 2; ++n) acc[a][b][m][n] = (f32x4){0.f, 0.f, 0.f, 0.f};
    bf16x8 At[4][2], B0[2][2], B1[2][2];
    const char* cA = (const char*)g.A + (size_t)cur.pm * tstep; const char* cB = (const char*)g.Bt + (size_t)cur.pn * tstep;
    S.a_ready(cur);
    PG8_STAGE(PG8_SB(0, 0), cB, voffB); PG8_STAGE(PG8_SA(0, 0), cA, voffA); PG8_STAGE(PG8_SB(0, 1), cB + hstep, voffB); PG8_STAGE(PG8_SA(0, 1), cA + hstep, voffA);
    if (wr == 1) PG8_BAR;
    PG8_WAIT_V(4); PG8_BAR;
    PG8_STAGE(PG8_SB(1, 0), cB + kstep, voffB); PG8_STAGE(PG8_SA(1, 0), cA + kstep, voffA); PG8_STAGE(PG8_SB(1, 1), cB + hstep + kstep, voffB);
    PG8_WAIT_V(6); PG8_BAR;
    PG8_STAMP();
    for (;;) {
        const bool has_next = S.next(ui + 1, nxt);
        const char* nA = has_next ? (const char*)g.A + (size_t)nxt.pm * tstep : cA; const char* nB = has_next ? (const char*)g.Bt + (size_t)nxt.pn * tstep : cB;
        for (int t = 0; t < nt; t += 2) {
            const bool last = (t == nt - 2);
            const char* a1 = cA + (size_t)(t + 1) * kstep;
            const char* a2 = last ? nA : cA + (size_t)(t + 2) * kstep; const char* b2 = last ? nB : cB + (size_t)(t + 2) * kstep;
            const char* a3 = a2 + kstep; const char* b3 = b2 + kstep;
            if (last && has_next) S.a_ready(nxt);
            PG8_LDB(B0, 0, 0); PG8_SCHED; PG8_LDA(At, 0, 0); PG8_STAGE(PG8_SA(1, 1), a1 + hstep, voffA);
            PG8_WAIT_L(8); PG8_BAR; PG8_WAIT_L(0); PG8_MMA(0, 0, At, B0); PG8_BAR; PG8_SCHED;
            PG8_LDB(B1, 0, 1); PG8_STAGE(PG8_SB(0, 0), b2, voffB);
            PG8_BAR; PG8_WAIT_L(0); PG8_MMA(0, 1, At, B1); PG8_BAR;
            PG8_LDA(At, 0, 1); PG8_STAGE(PG8_SA(0, 0), a2, voffA);
            PG8_BAR; PG8_WAIT_L(0); PG8_MMA(1, 0, At, B0); PG8_BAR; PG8_SCHED;
            PG8_STAGE(PG8_SB(0, 1), b2 + hstep, voffB);
            PG8_WAIT_V(6); PG8_BAR; PG8_MMA(1, 1, At, B1); PG8_BAR;
            PG8_LDB(B0, 1, 0); PG8_SCHED; PG8_LDA(At, 1, 0); PG8_STAGE(PG8_SA(0, 1), a2 + hstep, voffA);
            PG8_WAIT_L(8); PG8_BAR; PG8_WAIT_L(0); PG8_MMA(0, 0, At, B0); PG8_BAR; PG8_SCHED;
            PG8_LDB(B1, 1, 1); PG8_STAGE(PG8_SB(1, 0), b3, voffB);
            PG8_BAR; PG8_WAIT_L(0); PG8_MMA(0, 1, At, B1); PG8_BAR;
            PG8_LDA(At, 1, 1); PG8_STAGE(PG8_SA(1, 0), a3, voffA);
            PG8_BAR; PG8_WAIT_L(0); PG8_MMA(1, 0, At, B0); PG8_BAR; PG8_SCHED;
            PG8_STAGE(PG8_SB(1, 1), b3 + hstep, voffB);
            PG8_WAIT_V(6); PG8_BAR; PG8_MMA(1, 1, At, B1); PG8_BAR;
        }
        PG8_STAMP();
        if constexpr (!Epi::AFTER_DRAIN) { E(acc, cur, wr, wc, fr, fq); S.done(cur); }
        PG8_STAMP();
        if (!has_next) break;
#pragma unroll
        for (int a = 0; a < 2; ++a)
#pragma unroll
            for (int b = 0; b < 2; ++b)
#pragma unroll
                for (int m = 0; m < 4; ++m)
#pragma unroll
                    for (int n = 0; n < 2; ++n) acc[a][b][m][n] = (f32x4){0.f, 0.f, 0.f, 0.f};
        cur = nxt; cA = nA; cB = nB; ++ui;
    }
    PG8_WAIT_V(0);
    if (wr == 0) PG8_BAR;
    PG8_BAR;
    if constexpr (Epi::AFTER_DRAIN) { E.fused(acc, cur, wr, wc, fr, fq, lds, wid, lane); S.done(cur); }
    PG8_STAMP();
    if (STAMP && wid == 0) { stamps[lane] = lane < nts ? (((unsigned long long)(unsigned)ts_hi << 32) | (unsigned)ts_lo) : 0ull;
        if (lane == 62) stamps[62] = rt_entry; if (lane == 63) stamps[63] = (unsigned long long)wall_clock64(); }
#undef PG8_STAMP
#undef PG8_SA
#undef PG8_SB
#undef PG8_STAGE
#undef PG8_LDA
#undef PG8_LDB
#undef PG8_MMA
#undef PG8_WAIT_V
#undef PG8_WAIT_L
#undef PG8_BAR
#undef PG8_SCHED
}
}

struct EpiAct {
  static constexpr bool PERM = true, AFTER_DRAIN = false;
  u16* act;
  DI void operator()(const f32x4 (&acc)[2][2][4][2], const pg8::Unit& u, int wr, int wc, int fr, int fq) const {
    const int row0 = u.pm * 256 + wr * 64 + fr, col0 = u.pn * 128 + wc * 32 + 8 * fq;
#pragma unroll
    for (int ai = 0; ai < 2; ++ai)
#pragma unroll
      for (int m = 0; m < 4; ++m) {
        u16* rowp = act + (size_t)(row0 + ai * 128 + m * 16) * DFF + col0;
        float o[8];
#pragma unroll
        for (int n = 0; n < 2; ++n)
#pragma unroll
          for (int j = 0; j < 4; ++j) { float g = acc[ai][0][m][n][j], up = acc[ai][1][m][n][j]; o[n * 4 + j] = g * up * __builtin_amdgcn_rcpf(1.f + __builtin_amdgcn_exp2f(-1.4426950408889634f * g)); }
        uint4 w; w.x = pack2(o[0], o[1]); w.y = pack2(o[2], o[3]); w.z = pack2(o[4], o[5]); w.w = pack2(o[6], o[7]);
        *(uint4*)rowp = w;
      }
  }
};
struct EpiRes {
  static constexpr bool PERM = false, AFTER_DRAIN = false;
  float* xlat; float* xctx; const float* modl; int gidx; float coef;
  DI void operator()(const f32x4 (&acc)[2][2][4][2], const pg8::Unit& u, int wr, int wc, int fr, int fq) const {
    const int brow = u.pm * 256;
    const int e = brow < MLAT ? brow >> 12 : 8;
    float* xb = (brow < MLAT ? xlat + (size_t)brow * D : xctx + (size_t)(brow - MLAT) * D) + (size_t)(wr * 64 + fr) * D;
    const int col0 = u.pn * 256 + wc * 32 + 4 * fq;
    const float* mg = modl + (size_t)e * 9216 + gidx * 1024 + col0;
    f32x4 gm[2][2];
#pragma unroll
    for (int bj = 0; bj < 2; ++bj)
#pragma unroll
      for (int n = 0; n < 2; ++n) gm[bj][n] = *(const f32x4*)(mg + bj * 128 + n * 16) * coef;
#pragma unroll
    for (int ai = 0; ai < 2; ++ai)
#pragma unroll
      for (int m = 0; m < 4; ++m) {
        float* rowp = xb + (size_t)(ai * 128 + m * 16) * D + col0;
#pragma unroll
        for (int bj = 0; bj < 2; ++bj)
#pragma unroll
          for (int n = 0; n < 2; ++n) {
            f32x4* xp = (f32x4*)(rowp + bj * 128 + n * 16);
            *xp = *xp + gm[bj][n] * acc[ai][bj][m][n];
          }
      }
  }
};
struct EpiP {
  static constexpr bool PERM = true, AFTER_DRAIN = false;
  u16* P; int ld; int nvalid; float one;
  DI void operator()(const f32x4 (&acc)[2][2][4][2], const pg8::Unit& u, int wr, int wc, int fr, int fq) const {
    const int row0 = u.pm * 256 + wr * 64 + fr, col0 = u.pn * 256 + wc * 32 + 8 * fq;
#pragma unroll
    for (int ai = 0; ai < 2; ++ai)
#pragma unroll
      for (int m = 0; m < 4; ++m) {
        u16* rowp = P + (size_t)(row0 + ai * 128 + m * 16) * ld + col0;
#pragma unroll
        for (int bj = 0; bj < 2; ++bj) {
          if (col0 + bj * 128 < nvalid) {
            const f32x4 v0 = acc[ai][bj][m][0] * one, v1 = acc[ai][bj][m][1] * one;
            uint4 w; w.x = pack2(v0[0], v0[1]); w.y = pack2(v0[2], v0[3]); w.z = pack2(v1[0], v1[1]); w.w = pack2(v1[2], v1[3]);
            *(uint4*)(rowp + bj * 128) = w;
          }
        }
      }
  }
};

template <class Epi>
DI void gemm_phase(const u16* A, const u16* Bt, int Mrows, int N, int K, const Epi& epi) {
  pg8::Gemm g{A, Bt, Mrows, N, K};
  pg8::StaticOrder S; S.init(Mrows, N, (int)gridDim.x, obid());
  pg8::gemm_phase<Epi, pg8::StaticOrder, false>((PG8_LAS unsigned char*)g_lds, g, S, epi, nullptr);
}

template <bool EVEN>
__device__ void phase_feat_t(const Params& p, int l) {
  const int tid = otid(), lane = tid & 63, wave = tid >> 6;
  const int e = l >> 1;
  constexpr int NQ = EVEN ? 8 : 16, NKV = EVEN ? 2 : 4, ld = EVEN ? EVC : ODC;
  constexpr int nch = NQ + 2 * NKV, NIT = nch / 2;
  const u16* P = (const u16*)(p.ws + WS_ACT);
  u16* Q = (u16*)(p.ws + WS_Q); u16* Kd = (u16*)(p.ws + WS_K); u16* Vt = (u16*)(p.ws + WS_VT);
  u16* vts = (u16*)g_lds;
  const int i = lane & 31;
  const float qg0 = p.in[10][e * 64 + 2 * i], qg1 = p.in[10][e * 64 + 2 * i + 1];
  const float kg0 = p.in[11][e * 64 + 2 * i], kg1 = p.in[11][e * 64 + 2 * i + 1];
  const float invf = exp2f(-(float)(i & 15) * (13.287712379549449f / 16.f));
  for (int g = obid(); g < MTOT / 64; g += gridDim.x) {
    const int row0 = g * 64; const bool lat = row0 < MLAT;
    int b, tok0;
    if (lat) { b = row0 >> 12; tok0 = row0 & 4095; } else { int r = row0 - MLAT; b = r >> 8; tok0 = 4096 + (r & 255); }
#pragma unroll 2
    for (int tj = 0; tj < 8; ++tj) {
      const int ti = wave + 8 * tj;
      const int row = row0 + ti, tok = tok0 + ti;
      unsigned pv[NIT];
      const u16* prow = P + (size_t)row * ld + (lane >> 5) * 64 + 2 * i;
#pragma unroll
      for (int it = 0; it < NIT; ++it) pv[it] = *(const unsigned*)(prow + it * 128);
      float cs = 1.f, sn = 0.f;
      if (lat) { float pos = (i < 16) ? (float)(tok >> 6) : (float)(tok & 63); float ang = pos * invf; cs = __cosf(ang); sn = __sinf(ang); }
#pragma unroll
      for (int it = 0; it < NIT; ++it) {
        const int ch = it * 2 + (lane >> 5);
        float x0 = bf2f((u16)(pv[it] & 0xffff)), x1 = bf2f((u16)(pv[it] >> 16));
        const bool isq = it * 2 < NQ, isk = !isq && it * 2 < NQ + NKV;
        if (EVEN && (isq || isk)) {
          float ss = row_sum16(x0 * x0 + x1 * x1);
          ss += __shfl_xor(ss, 16);
          float r = rsqrtf(ss * (1.f / 64.f) + 1e-6f);
          x0 *= r * (isq ? qg0 : kg0); x1 *= r * (isq ? qg1 : kg1);
        }
        if (isq || isk) {
          float y0 = x0 * cs - x1 * sn, y1 = x0 * sn + x1 * cs;
          if (isq) {
            const float sc = 0.125f * 1.4426950408889634f;
            *(unsigned*)(Q + ((size_t)(b * NQ + ch) * NTOK + tok) * 64 + 2 * i) = pack2(y0 * sc, y1 * sc);
          } else {
            *(unsigned*)(Kd + ((size_t)(b * NKV + (ch - NQ)) * NTOK + tok) * 64 + 2 * i) = pack2(y0, y1);
          }
        } else {
          int vr = (ch - NQ - NKV) * 64 + 2 * i;
          vts[vr * 72 + ti] = f2bf(x0); vts[(vr + 1) * 72 + ti] = f2bf(x1);
        }
      }
    }
    __syncthreads();
    for (int idx = tid; idx < NKV * 64 * 8; idx += 512) {
      int r = idx >> 3, seg = idx & 7; int kvh = r >> 6, d = r & 63;
      uint4 val = *(const uint4*)&vts[r * 72 + seg * 8];
      *(uint4*)(Vt + ((size_t)(b * NKV + kvh) * 64 + d) * NTOK + tok0 + seg * 8) = val;
    }
    __syncthreads();
  }
}
__device__ void phase_feat(const Params& p, int l) {
  if (l & 1) phase_feat_t<false>(p, l); else phase_feat_t<true>(p, l);
}

DI bf16x8 pack8(const f32x16& x, int s) {
  uint4 r;
  r.x = pack2(x[8 * s + 0], x[8 * s + 1]); r.y = pack2(x[8 * s + 2], x[8 * s + 3]);
  r.z = pack2(x[8 * s + 4], x[8 * s + 5]); r.w = pack2(x[8 * s + 6], x[8 * s + 7]);
  return __builtin_bit_cast(bf16x8, r);
}

__device__ void attn_item(const Params& p, int NQ, int NKV, int b, int kvh, int q0, bool windowed, bool has_sink, const float* sinkp) {
  const int tid = otid(), lane = tid & 63, wave = tid >> 6, r = lane & 31, h = lane >> 5;
  const u16* Q = (const u16*)(p.ws + WS_Q); const u16* Kd = (const u16*)(p.ws + WS_K); const u16* Vt = (const u16*)(p.ws + WS_VT);
  u16* O = (u16*)(p.ws + WS_H);
  const int head = kvh * 4 + (wave >> 1);
  const int qtok = q0 + (wave & 1) * 32 + r;
  const bool is_ctx = q0 >= 4096;
  const u16* qp = Q + ((size_t)(b * NQ + head) * NTOK + qtok) * 64;
  bf16x8 qf[4];
#pragma unroll
  for (int kk = 0; kk < 4; ++kk) qf[kk] = *(const bf16x8*)(qp + kk * 16 + h * 8);
  const u16* Kb = Kd + (size_t)(b * NKV + kvh) * NTOK * 64;
  const u16* Vb = Vt + (size_t)(b * NKV + kvh) * 64 * NTOK;
  int nt, nwin = 0, wlo = 0;
  if (is_ctx) { nt = 4; wlo = 4096; nwin = 0; }
  else if (windowed) { wlo = q0 - 128 < 128 ? 128 : q0 - 128; int whi = q0 + 192 > 4096 ? 4096 : q0 + 192; nwin = (whi - wlo) >> 6; nt = nwin + 4; }
  else { nt = 68; }
#define KSTART(it) (is_ctx ? 4096 + (it) * 64 : (windowed ? ((it) < nwin ? wlo + (it) * 64 : 4096 + ((it) - nwin) * 64) : (it) * 64))
  u16* Ks = (u16*)g_lds; u16* Vs = Ks + 2 * 64 * 72;
  const int lrow = tid >> 3, lseg = tid & 7;
  uint4 kreg, vreg;
  { int ks = KSTART(0);
    kreg = *(const uint4*)(Kb + (size_t)(ks + lrow) * 64 + lseg * 8);
    vreg = *(const uint4*)(Vb + (size_t)lrow * NTOK + ks + lseg * 8);
    *(uint4*)&Ks[lrow * 72 + lseg * 8] = kreg; *(uint4*)&Vs[lrow * 72 + lseg * 8] = vreg; }
  __syncthreads();
  f32x16 ot[2];
#pragma unroll
  for (int i = 0; i < 16; ++i) { ot[0][i] = 0.f; ot[1][i] = 0.f; }
  float mrun = -1e30f, lsum = 0.f;
  if (windowed && !is_ctx) { int nph = qtok + 129 - 4096; if (nph > 0) { mrun = 0.f; lsum = (float)nph; } }
  for (int it = 0; it < nt; ++it) {
    const int cur = it & 1;
    const u16* Kc = Ks + cur * 64 * 72; const u16* Vc = Vs + cur * 64 * 72;
    if (it + 1 < nt) { int ks = KSTART(it + 1);
      kreg = *(const uint4*)(Kb + (size_t)(ks + lrow) * 64 + lseg * 8);
      vreg = *(const uint4*)(Vb + (size_t)lrow * NTOK + ks + lseg * 8); }
    f32x16 st[2];
#pragma unroll
    for (int kt = 0; kt < 2; ++kt) {
#pragma unroll
      for (int i = 0; i < 16; ++i) st[kt][i] = 0.f;
#pragma unroll
      for (int kk = 0; kk < 4; ++kk) {
        bf16x8 kf = *(const bf16x8*)&Kc[(kt * 32 + r) * 72 + kk * 16 + h * 8];
        st[kt] = __builtin_amdgcn_mfma_f32_32x32x16_bf16(kf, qf[kk], st[kt], 0, 0, 0);
      }
    }
    if (windowed && it < nwin) {
      const int ks = KSTART(it);
#pragma unroll
      for (int kt = 0; kt < 2; ++kt)
#pragma unroll
        for (int i = 0; i < 16; ++i) {
          int key = ks + kt * 32 + (i & 3) + 8 * (i >> 2) + 4 * h;
          int dlt = key - qtok; dlt = dlt < 0 ? -dlt : dlt;
          if (dlt > 128) st[kt][i] = -1e30f;
        }
    }
    float mx = -1e30f;
#pragma unroll
    for (int kt = 0; kt < 2; ++kt)
#pragma unroll
      for (int i = 0; i < 16; ++i) mx = fmaxf(mx, st[kt][i]);
    mx = fmaxf(mx, __shfl_xor(mx, 32));
    const float mnew = fmaxf(mrun, mx);
    const float alpha = __builtin_amdgcn_exp2f(mrun - mnew);
    float rs = 0.f;
#pragma unroll
    for (int kt = 0; kt < 2; ++kt)
#pragma unroll
      for (int i = 0; i < 16; ++i) {
        float sv = st[kt][i];
        float pe = sv <= -1e29f ? 0.f : __builtin_amdgcn_exp2f(sv - mnew);
        st[kt][i] = pe; rs += pe;
      }
    rs += __shfl_xor(rs, 32);
    lsum = lsum * alpha + rs;
    mrun = mnew;
#pragma unroll
    for (int i = 0; i < 16; ++i) { ot[0][i] *= alpha; ot[1][i] *= alpha; }
#pragma unroll
    for (int kt = 0; kt < 2; ++kt)
#pragma unroll
      for (int s = 0; s < 2; ++s) {
        bf16x8 pf = pack8(st[kt], s);
#pragma unroll
        for (int db = 0; db < 2; ++db) {
          const u16* vp = &Vc[(db * 32 + r) * 72 + kt * 32 + 16 * s + 4 * h];
          uint2 v0 = *(const uint2*)vp, v1 = *(const uint2*)(vp + 8);
          uint4 vv = make_uint4(v0.x, v0.y, v1.x, v1.y);
          bf16x8 vf = __builtin_bit_cast(bf16x8, vv);
          ot[db] = __builtin_amdgcn_mfma_f32_32x32x16_bf16(vf, pf, ot[db], 0, 0, 0);
        }
      }
    if (it + 1 < nt) {
      u16* Kn = Ks + (cur ^ 1) * 64 * 72; u16* Vn = Vs + (cur ^ 1) * 64 * 72;
      *(uint4*)&Kn[lrow * 72 + lseg * 8] = kreg; *(uint4*)&Vn[lrow * 72 + lseg * 8] = vreg;
    }
    __syncthreads();
  }
#undef KSTART
  if (has_sink) lsum += __builtin_amdgcn_exp2f(sinkp[head] * 1.4426950408889634f - mrun);
  const float inv = 1.f / lsum;
  const size_t orow = is_ctx ? (size_t)MLAT + b * 256 + (qtok - 4096) : (size_t)b * 4096 + qtok;
  u16* op = O + orow * D + head * 64;
#pragma unroll
  for (int db = 0; db < 2; ++db)
#pragma unroll
    for (int g = 0; g < 4; ++g) {
      uint2 o;
      o.x = pack2(ot[db][4 * g + 0] * inv, ot[db][4 * g + 1] * inv);
      o.y = pack2(ot[db][4 * g + 2] * inv, ot[db][4 * g + 3] * inv);
      *(uint2*)(op + db * 32 + 8 * g + 4 * h) = o;
    }
}

DI void lbar() { asm volatile("s_waitcnt lgkmcnt(0)\n\ts_barrier" ::: "memory"); }
DI float fast_tanh(float x) { float e = __expf(2.f * x); return 1.f - 2.f / (e + 1.f); }
DI float dot16(const f32x4 (&s)[4], const f32x4& a0, const f32x4& a1, const f32x4& a2, const f32x4& a3) {
  f32x4 t = s[0] * a0; t += s[1] * a1; t += s[2] * a2; t += s[3] * a3;
  return (t[0] + t[1]) + (t[2] + t[3]);
}
__device__ void scan_chain(const Params& p, int e, int chain, int rep) {
  const int tid = otid(), lane = tid & 63, wave = __builtin_amdgcn_readfirstlane(tid >> 6);
  const int b = chain >> 4, h = (chain >> 1) & 7, d = chain & 1;
  const u16* P = (const u16*)(p.ws + WS_ACT);
  u16* Y = (u16*)(p.ws + WS_Y);
  float* sb0 = (float*)g_lds;
  float* bg0 = sb0 + 2 * 6144;
  float* part = bg0 + 2 * 128;
  float* yp0 = part + 512;
  float* tk = yp0 + 2 * 4096;
  u16* ttwb = (u16*)(tk + 1024);
  u16* talb = ttwb + 16 * 72;
  float* mus = tk + 1024 + 1152;
  const float* mu = p.in[12] + (size_t)e * 2 * 1920;
  auto chunk_geo = [&](int ci, int& t0, int& T, size_t& rowbase) {
    if (ci < 16) { T = 256; rowbase = (size_t)MLAT + b * 256; t0 = d ? 240 - ci * 16 : ci * 16; }
    else { T = 4096; rowbase = (size_t)b * 4096; int cj = ci - 16; t0 = d ? 4080 - cj * 16 : cj * 16; }
  };
  for (int i = tid; i < 640; i += 512) {
    int which = i / 320, r = i % 320; int seg = r >> 6, c = r & 63;
    int colb = seg == 0 ? h * 64 : seg == 1 ? 512 + h * 64 : seg == 2 ? 1024 + h * 64 : seg == 3 ? 1536 + d * 64 : 1664 + d * 64;
    mus[i] = mu[which * 1920 + colb + c];
  }
  lbar();
  if (wave < 4) {
    __builtin_amdgcn_s_setprio(3);
    f32x4 S[4];
#pragma unroll
    for (int j = 0; j < 4; ++j) S[j] = (f32x4){0.f, 0.f, 0.f, 0.f};
#pragma unroll 1
    for (int k = 0; k <= 272; ++k) {
      lbar();
      if (k == 0 || (SCANMODE >= 1 && rep == 0)) {
#pragma unroll 1
        for (int t = 0; t < 16; ++t) lbar();
        continue;
      }
      const float* sb = sb0 + ((k - 1) & 1) * 6144; const float* bg = bg0 + ((k - 1) & 1) * 128; float* yp = yp0 + ((k - 1) & 1) * 4096;
      const float* sbw = sb + wave * 16;
      { const f32x4* kp = (const f32x4*)(sbw + 4 * 64);
        part[wave * 64 + lane] = dot16(S, kp[0], kp[1], kp[2], kp[3]); }
      f32x4 wA[4], nA[4]; float viA; float2 gA;
      f32x4 wB[4], nB[4]; float viB; float2 gB;
#define LOADSTEP(t_, X) do { const float* s_ = sbw + (t_) * 384; \
        _Pragma("unroll") for (int j = 0; j < 4; ++j) { w##X[j] = *(const f32x4*)(s_ + 1 * 64 + 4 * j); n##X[j] = *(const f32x4*)(s_ + 384 + 4 * 64 + 4 * j); } \
        vi##X = sb[(t_) * 384 + 3 * 64 + lane]; g##X = *(const float2*)&bg[((t_) * 4 + wave) * 2]; } while (0)
#define STEP(t_, X, Y_) do { \
        lbar(); \
        const float* pp = part + ((t_) & 1) * 256; \
        float q0 = pp[lane], q1 = pp[64 + lane], q2 = pp[128 + lane], q3 = pp[192 + lane]; \
        f32x4 b_[4], k_[4], r_[4]; \
        { const float* s_ = sbw + (t_) * 384; \
          _Pragma("unroll") for (int j = 0; j < 4; ++j) { b_[j] = *(const f32x4*)(s_ + 5 * 64 + 4 * j); k_[j] = *(const f32x4*)(s_ + 2 * 64 + 4 * j); } \
          _Pragma("unroll") for (int j = 0; j < 4; ++j) r_[j] = *(const f32x4*)(s_ + 0 * 64 + 4 * j); } \
        if ((t_) < 15) LOADSTEP((t_) + 1, Y_); \
        f32x4 Dv[4]; \
        _Pragma("unroll") for (int j = 0; j < 4; ++j) Dv[j] = S[j] * w##X[j]; \
        float A = dot16(Dv, n##X[0], n##X[1], n##X[2], n##X[3]); \
        float sa = (q0 + q1) + (q2 + q3); \
        if ((t_) < 15) part[(((t_) + 1) & 1) * 256 + wave * 64 + lane] = A - sa * g##X.x + vi##X * g##X.y; \
        _Pragma("unroll") for (int j = 0; j < 4; ++j) S[j] = Dv[j] - b_[j] * sa + k_[j] * vi##X; \
        yp[((t_) * 4 + wave) * 64 + lane] = dot16(S, r_[0], r_[1], r_[2], r_[3]); } while (0)
      LOADSTEP(0, A);
#pragma unroll 1
      for (int t = 0; t < 16; t += 2) { STEP(t, A, B); STEP(t + 1, B, A); }
#undef LOADSTEP
#undef STEP
    }
    __builtin_amdgcn_s_setprio(0);
  } else {
    const int pw = wave - 4;
    const int cB = pw * 16 + (lane & 15);
    bf16x8 wfW[2], wfA[2];
    { const float* W = p.in[14] + (size_t)(e * 2 + d) * 64 * 512 + h * 64 + cB;
      const float* Am = p.in[16] + (size_t)(e * 2 + d) * 64 * 512 + h * 64 + cB;
#pragma unroll
      for (int ks = 0; ks < 2; ++ks)
#pragma unroll
        for (int j = 0; j < 8; ++j) { size_t ro = (size_t)(ks * 32 + 8 * (lane >> 4) + j) * 512; wfW[ks][j] = (short)f2bf(W[ro]); wfA[ks][j] = (short)f2bf(Am[ro]); } }
    const float kkc = p.in[18][e * 512 + h * 64 + lane];
    const float kacB = p.in[19][e * 512 + h * 64 + cB];
    const float w0cB = p.in[13][(e * 2 + d) * 512 + h * 64 + cB], a0cB = p.in[15][(e * 2 + d) * 512 + h * 64 + cB];
    float m0[5], m1[5];
#pragma unroll
    for (int seg = 0; seg < 5; ++seg) { m0[seg] = mus[seg * 64 + lane]; m1[seg] = mus[320 + seg * 64 + lane]; }
    u16 pvP[20], pvC[20], pvN[20];
    int t0n = 0, Tn = 1; const u16* rowp0 = P;
#define LOADGEO(ci_) do { size_t rbn_; chunk_geo((ci_), t0n, Tn, rbn_); rowp0 = P + (rbn_ + (size_t)t0n) * EVC + RW; } while (0)
#define LOADITEM(u_, seg_) do { \
      const int i_ = pw + 4 * (u_); const int rel_ = d ? 15 - i_ : i_; const int pos_ = t0n + rel_; \
      const int colb_ = (seg_) == 0 ? h * 64 : (seg_) == 1 ? 512 + h * 64 : (seg_) == 2 ? 1024 + h * 64 : (seg_) == 3 ? 1536 + d * 64 : 1664 + d * 64; \
      const u16* sp_ = rowp0 + (rel_ * EVC + colb_);     \
        \
      pvC[(u_) * 5 + (seg_)] = sp_[lane]; pvP[(u_) * 5 + (seg_)] = (sp_ - (pos_ > 0 ? EVC : 0))[lane]; \
      pvN[(u_) * 5 + (seg_)] = (sp_ + (pos_ < Tn - 1 ? EVC : 0))[lane]; } while (0)
#define STEPA(u_, seg_) do { const int i_ = pw + 4 * (u_); const int posa_ = d ? ta0 + 15 - i_ : ta0 + i_; \
      const float cur_ = bf2f(pvC[(u_) * 5 + (seg_)]), prv_ = posa_ > 0 ? bf2f(pvP[(u_) * 5 + (seg_)]) : 0.f, nxt_ = posa_ < Ta - 1 ? bf2f(pvN[(u_) * 5 + (seg_)]) : 0.f; \
      const float f_ = cur_ + m0[(seg_)] * (prv_ - cur_) + m1[(seg_)] * (nxt_ - cur_); \
      if ((seg_) == 0) sb[(i_ * 6 + 0) * 64 + lane] = f_; \
      else if ((seg_) == 1) { tk[i_ * 64 + lane] = f_; float kn_ = f_ * kkc; float ss_ = wave_sum(kn_ * kn_); sb[(i_ * 6 + 4) * 64 + lane] = kn_ * rsqrtf(ss_ + 1e-6f); } \
      else if ((seg_) == 2) sb[(i_ * 6 + 3) * 64 + lane] = f_; \
      else if ((seg_) == 3) ttwb[i_ * 72 + lane] = f2bf(fast_tanh(f_)); \
      else talb[i_ * 72 + lane] = f2bf(f_); } while (0)
    LOADGEO(0);
#pragma unroll
    for (int u = 0; u < 4; ++u)
#pragma unroll
      for (int seg = 0; seg < 5; ++seg) LOADITEM(u, seg);
#pragma unroll 1
    for (int k = 0; k <= 272; ++k) {
      float* sb = sb0 + (k & 1) * 6144; float* bg = bg0 + (k & 1) * 128; const float* ypf = yp0 + (k & 1) * 4096;
      const bool prep = k < 272 && !(SCANMODE == 2 && rep == 0);
      const bool nxt = k + 1 < 272;
      int ta0 = 0, Ta = 1; { size_t rba_; if (k < 272) chunk_geo(k, ta0, Ta, rba_); }
      lbar();
      if (prep) { STEPA(0, 0); STEPA(0, 1); }
      lbar();
      if (prep) { STEPA(0, 2); STEPA(0, 3); }
      lbar();
      if (prep) { STEPA(0, 4); STEPA(1, 0); }
      lbar();
      if (prep) { STEPA(1, 1); STEPA(1, 2); }
      lbar();
      if (prep) { STEPA(1, 3); STEPA(1, 4); }
      lbar();
      if (prep) { STEPA(2, 0); STEPA(2, 1); }
      lbar();
      if (prep) { STEPA(2, 2); STEPA(2, 3); }
      lbar();
      if (prep) { STEPA(2, 4); STEPA(3, 0); }
      lbar();
      if (prep) { STEPA(3, 1); STEPA(3, 2); }
      lbar();
      if (prep) { STEPA(3, 3); STEPA(3, 4); }
      lbar();
      if (prep) {
        const int ao = (lane & 15) * 72 + 8 * (lane >> 4);
        bf16x8 t0_ = *(const bf16x8*)(ttwb + ao), t1_ = *(const bf16x8*)(ttwb + ao + 32);
        bf16x8 l0_ = *(const bf16x8*)(talb + ao), l1_ = *(const bf16x8*)(talb + ao + 32);
        f32x4 accW = (f32x4){0.f, 0.f, 0.f, 0.f}, accA = (f32x4){0.f, 0.f, 0.f, 0.f};
        accW = __builtin_amdgcn_mfma_f32_16x16x32_bf16(t0_, wfW[0], accW, 0, 0, 0);
        accW = __builtin_amdgcn_mfma_f32_16x16x32_bf16(t1_, wfW[1], accW, 0, 0, 0);
        accA = __builtin_amdgcn_mfma_f32_16x16x32_bf16(l0_, wfA[0], accA, 0, 0, 0);
        accA = __builtin_amdgcn_mfma_f32_16x16x32_bf16(l1_, wfA[1], accA, 0, 0, 0);
#pragma unroll
        for (int rg = 0; rg < 4; ++rg) {
          const int i = 4 * (lane >> 4) + rg;
          float xx = -(w0cB + accW[rg]);
          float sp = fmaxf(xx, 0.f) + __logf(1.f + __expf(-fabsf(xx)));
          float ee = __expf(-sp - 0.5f);
          sb[(i * 6 + 1) * 64 + cB] = __expf(-ee);
          float a = __builtin_amdgcn_rcpf(1.f + __expf(-(a0cB + accA[rg])));
          const float kdv = tk[i * 64 + cB] * (1.f + (a - 1.f) * kacB);
          const float bv = sb[(i * 6 + 4) * 64 + cB] * a;
          sb[(i * 6 + 2) * 64 + cB] = kdv;
          sb[(i * 6 + 5) * 64 + cB] = bv;
          const float kkn = i < 15 ? sb[((i + 1) * 6 + 4) * 64 + cB] : 0.f;
          const float bb = row_sum16(bv * kkn), gg = row_sum16(kdv * kkn);
          if ((lane & 15) == 0 && i < 15) { bg[(i * 4 + pw) * 2] = bb; bg[(i * 4 + pw) * 2 + 1] = gg; }
        }
      }
      lbar();
      if (nxt) { LOADGEO(k + 1); LOADITEM(0, 0); LOADITEM(0, 1); LOADITEM(0, 2); LOADITEM(0, 3); LOADITEM(0, 4);
                 LOADITEM(1, 0); LOADITEM(1, 1); LOADITEM(1, 2); LOADITEM(1, 3); LOADITEM(1, 4); }
      lbar();
      if (nxt) { LOADITEM(2, 0); LOADITEM(2, 1); LOADITEM(2, 2); LOADITEM(2, 3); LOADITEM(2, 4);
                 LOADITEM(3, 0); LOADITEM(3, 1); LOADITEM(3, 2); LOADITEM(3, 3); LOADITEM(3, 4); }
      lbar();
      if (k >= 2) {
        int t0, T; size_t rowbase; chunk_geo(k - 2, t0, T, rowbase);
#pragma unroll
        for (int u = 0; u < 4; ++u) {
          const int s = pw * 4 + u;
          float yv = (ypf[(s * 4 + 0) * 64 + lane] + ypf[(s * 4 + 1) * 64 + lane]) + (ypf[(s * 4 + 2) * 64 + lane] + ypf[(s * 4 + 3) * 64 + lane]);
          int pos = d ? t0 + 15 - s : t0 + s;
          Y[((rowbase + pos) * 2 + d) * 512 + h * 64 + lane] = f2bf(yv);
        }
      }
      lbar();
      lbar();
      lbar();
    }
#undef LOADITEM
#undef LOADGEO
#undef STEPA
  }
  lbar();
  {
    const float* ypf = yp0 + (271 & 1) * 4096;
    int t0, T; size_t rowbase; chunk_geo(271, t0, T, rowbase);
#pragma unroll
    for (int u = 0; u < 2; ++u) {
      const int s = wave + 8 * u;
      float yv = (ypf[(s * 4 + 0) * 64 + lane] + ypf[(s * 4 + 1) * 64 + lane]) + (ypf[(s * 4 + 2) * 64 + lane] + ypf[(s * 4 + 3) * 64 + lane]);
      int pos = d ? t0 + 15 - s : t0 + s;
      Y[((rowbase + pos) * 2 + d) * 512 + h * 64 + lane] = f2bf(yv);
    }
  }
  lbar();
}

__device__ void phase_mix(const Params& p, int l, int rep) {
  const bool even = !(l & 1); const int e = l >> 1;
  if (even && !(rep == 0 && DUPSKIP == 2)) { for (int ch = obid(); ch < 128; ch += gridDim.x) scan_chain(p, e, ch, rep); }
  if (rep == 0 && DUPSKIP == 1) return;
  const int NQ = even ? 8 : 16, NKV = even ? 2 : 4;
  const int nlat = 8 * NKV * 64, nctx = (l == 3) ? 0 : 8 * NKV * 4;
  unsigned* cnt = (unsigned*)(p.ws + WS_CNT) + l + (rep ? 0 : 8);
  volatile int* slot = (volatile int*)(g_lds + 40960);
  const float* sinkp = even ? nullptr : p.in[25] + e * 16;
  for (;;) {
    __syncthreads();
    if (otid() == 0) *slot = (int)atomicAdd(cnt, 1u);
    __syncthreads();
    int item = *slot;
    if (item >= nlat + nctx) break;
    int b, kvh, q0;
    if (item < nlat) { int qt = item & 63; int r = item >> 6; kvh = r % NKV; b = r / NKV; q0 = qt * 64; }
    else { int it2 = item - nlat; int qt = it2 & 3; int r = it2 >> 2; kvh = r % NKV; b = r / NKV; q0 = 4096 + qt * 64; }
    attn_item(p, NQ, NKV, b, kvh, q0, !even, !even, sinkp);
  }
}

__device__ void phase_readout(const Params& p, int e) {
  const int tid = otid(), lane = tid & 63, wave = __builtin_amdgcn_readfirstlane(tid >> 6);
  const u16* P = (const u16*)(p.ws + WS_ACT);
  const u16* Y = (const u16*)(p.ws + WS_Y);
  u16* O = (u16*)(p.ws + WS_H);
  u16* sgb = (u16*)g_lds;
  const float* mu = p.in[12] + (size_t)e * 2 * 1920;
  const float* g2 = p.in[17] + (size_t)e * 128 * 512;
  const int l15 = lane & 15, lq = lane >> 4;
  bf16x8 gf[4][4];
#pragma unroll
  for (int ks = 0; ks < 4; ++ks)
#pragma unroll
    for (int nt = 0; nt < 4; ++nt)
#pragma unroll
      for (int j = 0; j < 8; ++j) gf[ks][nt][j] = (short)f2bf(g2[(size_t)(ks * 32 + 8 * lq + j) * 512 + wave * 64 + nt * 16 + l15]);
  float gnw[4], gnb[4], rkc[4], mr0[4], mr1[4], mk0[4], mk1[4], mv0[4], mv1[4];
#pragma unroll
  for (int nt = 0; nt < 4; ++nt) {
    const int c = wave * 64 + nt * 16 + l15;
    gnw[nt] = p.in[21][e * 512 + c]; gnb[nt] = p.in[22][e * 512 + c]; rkc[nt] = p.in[20][e * 512 + c];
    mr0[nt] = mu[c]; mr1[nt] = mu[1920 + c]; mk0[nt] = mu[512 + c]; mk1[nt] = mu[1920 + 512 + c]; mv0[nt] = mu[1024 + c]; mv1[nt] = mu[1920 + 1024 + c];
  }
  const int gq = tid & 31, gt = tid >> 5;
  float mg0[4], mg1[4];
#pragma unroll
  for (int j = 0; j < 4; ++j) { mg0[j] = mu[1792 + 4 * gq + j]; mg1[j] = mu[1920 + 1792 + 4 * gq + j]; }
  for (int tile = obid(); tile < MTOT / 32; tile += gridDim.x) {
    const int row0 = tile * 32; const bool lat = row0 < MLAT;
    const int T = lat ? 4096 : 256; const int pos0 = lat ? (row0 & 4095) : ((row0 - MLAT) & 255);
#pragma unroll
    for (int u = 0; u < 2; ++u) {
      const int ti = gt + 16 * u; const int row = row0 + ti, pos = pos0 + ti;
      const u16* gp = P + (size_t)row * EVC + RW + 1792 + 4 * gq;
      const uint2 cu = *(const uint2*)gp;
      const uint2 pu = pos > 0 ? *(const uint2*)(gp - EVC) : make_uint2(0u, 0u);
      const uint2 nu = pos < T - 1 ? *(const uint2*)(gp + EVC) : make_uint2(0u, 0u);
      float cf[4] = {__uint_as_float(cu.x << 16), __uint_as_float(cu.x & 0xffff0000u), __uint_as_float(cu.y << 16), __uint_as_float(cu.y & 0xffff0000u)};
      float pf[4] = {__uint_as_float(pu.x << 16), __uint_as_float(pu.x & 0xffff0000u), __uint_as_float(pu.y << 16), __uint_as_float(pu.y & 0xffff0000u)};
      float nf[4] = {__uint_as_float(nu.x << 16), __uint_as_float(nu.x & 0xffff0000u), __uint_as_float(nu.y << 16), __uint_as_float(nu.y & 0xffff0000u)};
      float sgv[4];
#pragma unroll
      for (int j = 0; j < 4; ++j) { float f = cf[j] + mg0[j] * (pf[j] - cf[j]) + mg1[j] * (nf[j] - cf[j]); sgv[j] = __builtin_amdgcn_rcpf(1.f + __expf(-f)); }
      uint2 o; o.x = pack2(sgv[0], sgv[1]); o.y = pack2(sgv[2], sgv[3]);
      *(uint2*)&sgb[ti * 136 + 4 * gq] = o;
    }
    __syncthreads();
    f32x4 acc[2][4];
#pragma unroll
    for (int mt = 0; mt < 2; ++mt)
#pragma unroll
      for (int nt = 0; nt < 4; ++nt) acc[mt][nt] = (f32x4){0.f, 0.f, 0.f, 0.f};
#pragma unroll
    for (int mt = 0; mt < 2; ++mt)
#pragma unroll
      for (int ks = 0; ks < 4; ++ks) {
        const bf16x8 af = *(const bf16x8*)&sgb[(mt * 16 + l15) * 136 + ks * 32 + 8 * lq];
#pragma unroll
        for (int nt = 0; nt < 4; ++nt) acc[mt][nt] = __builtin_amdgcn_mfma_f32_16x16x32_bf16(af, gf[ks][nt], acc[mt][nt], 0, 0, 0);
      }
#pragma unroll
    for (int mt = 0; mt < 2; ++mt)
#pragma unroll
      for (int rg = 0; rg < 4; ++rg) {
        const int ti = mt * 16 + 4 * lq + rg; const int row = row0 + ti, pos = pos0 + ti;
        const bool hp = pos > 0, hn = pos < T - 1;
        const int offp = hp ? -EVC : 0, offn = hn ? EVC : 0;
        const u16* pr = P + (size_t)row * EVC + RW + wave * 64 + l15;
        const u16* yr = Y + (size_t)row * 1024 + wave * 64 + l15;
        u16 yv[4][2], cv[4][3], pv[4][3], nv[4][3];
#pragma unroll
        for (int nt = 0; nt < 4; ++nt) {
          yv[nt][0] = yr[nt * 16]; yv[nt][1] = yr[512 + nt * 16];
#pragma unroll
          for (int w = 0; w < 3; ++w) {
            cv[nt][w] = pr[w * 512 + nt * 16];
            pv[nt][w] = pr[w * 512 + nt * 16 + offp];
            nv[nt][w] = pr[w * 512 + nt * 16 + offn];
          }
        }
        float y[4], rs[4], ks_[4], vs[4];
        float ysum = 0.f, rksum = 0.f;
#pragma unroll
        for (int nt = 0; nt < 4; ++nt) {
          y[nt] = bf2f(yv[nt][0]) + bf2f(yv[nt][1]); ysum += y[nt];
          const float rc = bf2f(cv[nt][0]), kc = bf2f(cv[nt][1]), vc = bf2f(cv[nt][2]);
          const float pm = hp ? 1.f : 0.f, nm = hn ? 1.f : 0.f;
          rs[nt] = rc + mr0[nt] * (pm * bf2f(pv[nt][0]) - rc) + mr1[nt] * (nm * bf2f(nv[nt][0]) - rc);
          ks_[nt] = kc + mk0[nt] * (pm * bf2f(pv[nt][1]) - kc) + mk1[nt] * (nm * bf2f(nv[nt][1]) - kc);
          vs[nt] = vc + mv0[nt] * (pm * bf2f(pv[nt][2]) - vc) + mv1[nt] * (nm * bf2f(nv[nt][2]) - vc);
          rksum += rs[nt] * ks_[nt] * rkc[nt];
        }
        const float mean = row_sum16(ysum) * (1.f / 64.f);
        float vsum = 0.f;
#pragma unroll
        for (int nt = 0; nt < 4; ++nt) { y[nt] -= mean; vsum += y[nt] * y[nt]; }
        const float rstd = rsqrtf(row_sum16(vsum) * (1.f / 64.f) + 64e-5f);
        const float bsum = row_sum16(rksum);
        u16* orow = O + (size_t)row * D + 512 + wave * 64 + l15;
#pragma unroll
        for (int nt = 0; nt < 4; ++nt) orow[nt * 16] = f2bf((y[nt] * rstd * gnw[nt] + gnb[nt] + bsum * vs[nt]) * acc[mt][nt][rg]);
      }
    __syncthreads();
  }
}

__device__ void phase_final(const Params& p) {
  const int tid_ = otid(); const int lane = tid_ & 63, wave = tid_ >> 6;
  const float* fg = p.in[26];
  for (int row = obid() * 8 + wave; row < MLAT; row += gridDim.x * 8) {
    float4* xr = (float4*)(p.out + (size_t)row * D);
    float4 v[4]; float ss = 0.f;
#pragma unroll
    for (int q = 0; q < 4; ++q) { v[q] = xr[lane + q * 64]; ss += v[q].x * v[q].x + v[q].y * v[q].y + v[q].z * v[q].z + v[q].w * v[q].w; }
    ss = wave_sum(ss);
    float rstd = rsqrtf(ss * (1.f / 1024.f) + 1e-6f);
#pragma unroll
    for (int q = 0; q < 4; ++q) {
      float4 g = *(const float4*)(fg + (lane + q * 64) * 4);
      xr[lane + q * 64] = make_float4(v[q].x * rstd * g.x, v[q].y * rstd * g.y, v[q].z * rstd * g.z, v[q].w * rstd * g.w);
    }
  }
}

#define XB_TMO      128
#define XB_XCNT(j)  (256  + 64 * (j))
#define XB_XSUB(j)  (1280 + 64 * (j))
#define XB_XGEN(j)  (2304 + 64 * (j))
#define XB_TOP      3328
#define XB_TOPGEN   3392
#define XCD_BAR_WORDS 3456
#define XB_SPIN_CAP (1u << 18)
#define LAS __attribute__((address_space(3)))

__device__ __forceinline__ unsigned xb_ld(unsigned* p)              { return __hip_atomic_load(p, __ATOMIC_RELAXED, __HIP_MEMORY_SCOPE_AGENT); }
__device__ __forceinline__ unsigned xb_add(unsigned* p, unsigned v) { return __hip_atomic_fetch_add(p, v, __ATOMIC_RELAXED, __HIP_MEMORY_SCOPE_AGENT); }
__device__ __forceinline__ unsigned xb_xcc_id() { return (unsigned)__builtin_amdgcn_s_getreg((3 << 11) | 20) & 0xFu; }
#define XB_SPIN(cond, bar) do { unsigned _sp = 0; while (cond) { __builtin_amdgcn_s_sleep(1); \
    if ((++_sp & 255u) == 0u) { if (xb_ld(&(bar)[XB_TMO])) break; if (_sp > XB_SPIN_CAP) { atomicAdd(&(bar)[XB_TMO], 1u); break; } } } } while (0)

struct XcdBarrier {
    unsigned* bar; unsigned x;
    volatile LAS unsigned* st;
};

__device__ __forceinline__ XcdBarrier xcd_barrier_post(unsigned* bar, volatile LAS unsigned* st) {
    XcdBarrier b; b.bar = bar; b.x = xb_xcc_id(); b.st = st;
    if (threadIdx.x == 0) (void)xb_add(&bar[XB_XCNT(b.x)], 1u);
    return b;
}
__device__ __forceinline__ void xcd_barrier_complete(unsigned* bar, unsigned x, unsigned& nloc, unsigned& nx) {
    const unsigned G = gridDim.x * gridDim.y * gridDim.z;
    unsigned sum, cnt, mine, sp = 0u;
    for (;;) {
        sum = 0u; cnt = 0u; mine = 0u;
#pragma unroll
        for (unsigned j = 0; j < 16; ++j) { const unsigned c = xb_ld(&bar[XB_XCNT(j)]); sum += c; cnt += (c > 0u) ? 1u : 0u; mine = (j == x) ? c : mine; }
        if (sum == G) break;
        __builtin_amdgcn_s_sleep(1);
        if ((++sp & 255u) == 0u) { if (xb_ld(&bar[XB_TMO])) break; if (sp > XB_SPIN_CAP) { atomicAdd(&bar[XB_TMO], 1u); break; } }
    }
    nloc = mine > 0u ? mine : 1u; nx = cnt > 0u ? cnt : 1u;
}

__device__ __forceinline__ void xcd_barrier(const XcdBarrier& b) {
    asm volatile("s_waitcnt vmcnt(0)" ::: "memory");
    __syncthreads();
    if (threadIdx.x == 0) {
        unsigned* bar = b.bar;
        __builtin_amdgcn_s_waitcnt(0);
        unsigned nloc = b.st[0], nx = b.st[1];
        if (nloc == 0u) { xcd_barrier_complete(bar, b.x, nloc, nx); b.st[0] = nloc; b.st[1] = nx; }
        const unsigned old = xb_add(&bar[XB_XSUB(b.x)], 1u);
        const unsigned gen = old / nloc;
        if (old + 1u == (gen + 1u) * nloc) {
            __builtin_amdgcn_fence(__ATOMIC_RELEASE, "agent");
            asm volatile("s_waitcnt vmcnt(0)" ::: "memory");
            const unsigned og = xb_add(&bar[XB_TOP], 1u);
            const unsigned tg = og / nx;
            if (og + 1u == (tg + 1u) * nx) xb_add(&bar[XB_TOPGEN], 1u);
            else XB_SPIN(xb_ld(&bar[XB_TOPGEN]) == tg, bar);
            __builtin_amdgcn_fence(__ATOMIC_ACQUIRE, "agent");
            xb_add(&bar[XB_XGEN(b.x)], 1u);
            asm volatile("s_waitcnt vmcnt(0)" ::: "memory");
        } else {
            XB_SPIN(xb_ld(&bar[XB_XGEN(b.x)]) == gen, bar);
            __builtin_amdgcn_fence(__ATOMIC_ACQUIRE, "agent");
            asm volatile("s_waitcnt vmcnt(0)" ::: "memory");
        }
    }
    __syncthreads();
}


__device__ void run_phase(const Params& p, int ph, int rep) {
  if (ph == 0) { phase_setup(p); return; }
  if (ph == 1) { phase_mod(p); return; }
  if (ph == 50) { phase_final(p); return; }
  const int l = (ph - 2) / 12, s = (ph - 2) % 12;
  const bool even = !(l & 1); const int e = l >> 1;
  const int mrows_late = (l == 3) ? MLAT : MTOT;
  const float* modl = (const float*)(p.ws + WS_MOD) + (size_t)l * 9 * 9216;
  const u16* H = (const u16*)(p.ws + WS_H);
  u16* ACT = (u16*)(p.ws + WS_ACT);
  float* xctx = (float*)(p.ws + WS_XCTX);
  switch (s) {
    case 0: phase_prep(p, l, 0, MTOT); break;
    case 1: { EpiAct ep{ACT}; gemm_phase(H, (const u16*)(p.ws + WS_FFI) + (size_t)(l * 2 + 0) * 5632 * 1024, MTOT, 5632, 1024, ep); } break;
    case 2: { EpiRes ep{p.out, xctx, modl, 2, rep ? 0.5f : 0.f}; gemm_phase(ACT, (const u16*)(p.ws + WS_FFO) + (size_t)(l * 2 + 0) * 1024 * 2816, MTOT, 1024, 2816, ep); } break;
    case 3: phase_prep(p, l, 3, MTOT); break;
    case 4:
      if (even) { EpiP ep{ACT, EVC, EVC, 1.0f}; gemm_phase(H, (const u16*)(p.ws + WS_EVI) + (size_t)e * EVCP * 1024, MTOT, EVCP, 1024, ep); }
      else { EpiP ep{ACT, ODC, ODC, 1.0f}; gemm_phase(H, (const u16*)(p.ws + WS_ODI) + (size_t)e * ODC * 1024, MTOT, ODC, 1024, ep); }
      break;
    case 5: phase_feat(p, l); break;
    case 6: phase_mix(p, l, rep); break;
    case 7: if (even) phase_readout(p, e); break;
    case 8: { EpiRes ep{p.out, xctx, modl, 5, rep ? 1.0f : 0.f};
      gemm_phase(H, (const u16*)(p.ws + (even ? WS_EVO : WS_ODO)) + (size_t)e * 1024 * 1024, mrows_late, 1024, 1024, ep); } break;
    case 9: phase_prep(p, l, 6, mrows_late); break;
    case 10: { EpiAct ep{ACT}; gemm_phase(H, (const u16*)(p.ws + WS_FFI) + (size_t)(l * 2 + 1) * 5632 * 1024, mrows_late, 5632, 1024, ep); } break;
    case 11: { EpiRes ep{p.out, xctx, modl, 8, rep ? 0.5f : 0.f}; gemm_phase(ACT, (const u16*)(p.ws + WS_FFO) + (size_t)(l * 2 + 1) * 1024 * 2816, mrows_late, 1024, 2816, ep); } break;
  }
}

__global__ void __launch_bounds__(512, 2) mega(Params p, int ph_lo, int ph_hi) {
  cg::grid_group grid = cg::this_grid();
  volatile LAS unsigned* st = (volatile LAS unsigned*)(g_lds + 131072);
  XcdBarrier bar; bar.bar = (unsigned*)(p.ws + WS_BAR); bar.x = 0; bar.st = st;
  if (ph_hi - ph_lo > 1) {
    if (threadIdx.x < 2) st[threadIdx.x] = 0u;
    __syncthreads();
    bar = xcd_barrier_post((unsigned*)(p.ws + WS_BAR), st);
  }
  for (int ph = ph_lo; ph < ph_hi; ++ph) {
    int rep0 = 1;
#if DUP
    { bool dup = false;
      if (ph < 2) dup = (DUP & 32) != 0;
      else if (ph < 50) { int s_ = (ph - 2) % 12;
        dup = ((DUP & 1) && (s_ == 1 || s_ == 4 || s_ == 10)) || ((DUP & 2) && s_ == 6) || ((DUP & 4) && (s_ == 0 || s_ == 3 || s_ == 9)) ||
              ((DUP & 8) && (s_ == 5 || s_ == 7)) || ((DUP & 16) && (s_ == 2 || s_ == 8 || s_ == 11)); }
      if (dup) rep0 = 0; }
#endif
    if (ph >= 2 && ph < 50 && (ph - 2) % 12 == 7 && (((ph - 2) / 12) & 1)) continue;
#pragma unroll 1
    for (int rep = rep0; rep < 2; ++rep) {
      run_phase(p, ph, rep);
      if (rep == 0 || ph + 1 < ph_hi) {
        if (ph == ph_lo && rep == 1) grid.sync();
        else xcd_barrier(bar);
      }
    }
  }
}

extern "C" void kernel_launch(void* const* d_in, const int* in_sizes, int n_in, void* d_out, int out_size, void* d_ws, size_t ws_size,
                              hipStream_t stream) {
  static int grid = 0;
  if (grid == 0) {
    if (ws_size < WS_END) { fprintf(stderr, "kernel_launch: workspace too small: %zu < %zu\n", ws_size, (size_t)WS_END); grid = -1; return; }
    hipFuncSetAttribute((const void*)mega, hipFuncAttributeMaxDynamicSharedMemorySize, LDS_BYTES);
    int dev = 0, cus = 0, per_cu = 0;
    hipGetDevice(&dev);
    hipDeviceGetAttribute(&cus, hipDeviceAttributeMultiprocessorCount, dev);
    hipOccupancyMaxActiveBlocksPerMultiprocessor(&per_cu, (const void*)mega, 512, LDS_BYTES);
    if (per_cu < 1) per_cu = 1;
    grid = cus * 1;
    (void)hipGetLastError();
  }
  if (grid < 0) return;
  Params p{};
  for (int i = 0; i < 27; ++i) p.in[i] = (const float*)d_in[i];
  p.out = (float*)d_out; p.ws = (unsigned char*)d_ws;
#if MEGA
  hipMemsetAsync((unsigned char*)d_ws + WS_BAR, 0, 16384, stream);
  int lo = 0, hi = NPH;
  void* args[] = {&p, &lo, &hi};
  hipError_t e = hipLaunchCooperativeKernel((const void*)mega, dim3(grid), dim3(512), args, LDS_BYTES, stream);
  if (e != hipSuccess) fprintf(stderr, "cooperative launch failed: %s\n", hipGetErrorString(e));
#else
  for (int ph = 0; ph < NPH; ++ph) {
    if (ph >= 2 && ph < 50) { int l = (ph - 2) / 12, s = (ph - 2) % 12; if (s == 7 && (l & 1)) continue; }
    hipLaunchKernelGGL(mega, dim3(grid), dim3(512), LDS_BYTES, stream, p, ph, ph + 1);
  }
#endif
}
```

```cpp
#include <hip/hip_runtime.h>
#include <hip/hip_cooperative_groups.h>
#include <cstdio>
namespace cg = cooperative_groups;

#ifndef MEGA
#define MEGA 1
#endif
#ifndef DUP
#define DUP 0
#endif
#ifndef DUPSKIP
#define DUPSKIP 0
#endif
#ifndef SCANMODE
#define SCANMODE 0
#endif

typedef unsigned short u16;
using bf16x8 = __attribute__((ext_vector_type(8))) short;
using f32x4  = __attribute__((ext_vector_type(4))) float;
using f32x16 = __attribute__((ext_vector_type(16))) float;
#define DI __device__ __forceinline__

constexpr int D = 1024, MLAT = 32768, MCTX = 2048, MTOT = 34816, NTOK = 4352;
constexpr int DFF = 2816, EVC = 2688, EVCP = 2816, ODC = 1536, RW = 768;
constexpr int NPH = 51;
constexpr int LDS_BYTES = 131072 + 64;

constexpr size_t WS_FFI = 0;
constexpr size_t WS_FFO = WS_FFI + (size_t)8 * 5632 * 1024 * 2;
constexpr size_t WS_EVI = WS_FFO + (size_t)8 * 1024 * 2816 * 2;
constexpr size_t WS_EVO = WS_EVI + (size_t)2 * 2816 * 1024 * 2;
constexpr size_t WS_ODI = WS_EVO + (size_t)2 * 1024 * 1024 * 2;
constexpr size_t WS_ODO = WS_ODI + (size_t)2 * 1536 * 1024 * 2;
constexpr size_t WS_MOD = WS_ODO + (size_t)2 * 1024 * 1024 * 2;
constexpr size_t WS_XCTX = WS_MOD + (size_t)4 * 9 * 9216 * 4;
constexpr size_t WS_H = WS_XCTX + (size_t)MCTX * D * 4;
constexpr size_t WS_ACT = WS_H + (size_t)MTOT * D * 2;
constexpr size_t WS_Q = WS_ACT + (size_t)MTOT * DFF * 2;
constexpr size_t WS_K = WS_Q + (size_t)8 * 16 * NTOK * 64 * 2;
constexpr size_t WS_VT = WS_K + (size_t)8 * 4 * NTOK * 64 * 2;
constexpr size_t WS_Y = WS_VT + (size_t)8 * 4 * NTOK * 64 * 2;
constexpr size_t WS_CNT = WS_Y + (size_t)MTOT * 2 * 512 * 2;
constexpr size_t WS_BAR = WS_CNT + 256;
constexpr size_t WS_END = WS_BAR + 16384;

struct Params {
  const float* in[27];
  float* out;
  unsigned char* ws;
};

extern __shared__ __attribute__((aligned(16))) unsigned char g_lds[];

DI int otid() { int t = threadIdx.x; asm volatile("" : "+v"(t)); return t; }
DI int obid() { int b = blockIdx.x; asm volatile("" : "+s"(b)); return b; }
DI u16 f2bf(float f) { unsigned u = __float_as_uint(f); u += 0x7fffu + ((u >> 16) & 1u); return (u16)(u >> 16); }
DI float bf2f(u16 h) { return __uint_as_float(((unsigned)h) << 16); }
DI unsigned pack2(float a, float b) { unsigned r; asm("v_cvt_pk_bf16_f32 %0, %1, %2" : "=v"(r) : "v"(a), "v"(b)); return r; }
template <int CTRL, int RMASK> DI float dpp_add(float v) {
  return v + __int_as_float(__builtin_amdgcn_update_dpp(0, __float_as_int(v), CTRL, RMASK, 0xF, RMASK == 0xF));
}
DI float row_sum16(float v) {
  v = dpp_add<0xB1, 0xF>(v); v = dpp_add<0x4E, 0xF>(v); v = dpp_add<0x141, 0xF>(v); v = dpp_add<0x140, 0xF>(v);
  return v;
}
DI float wave_sum(float v) {
  v = row_sum16(v);
  v = dpp_add<0x142, 0xA>(v); v = dpp_add<0x143, 0xC>(v);
  return __int_as_float(__builtin_amdgcn_readlane(__float_as_int(v), 63));
}
DI float* xrow(const Params& p, int row) {
  return row < MLAT ? p.out + (size_t)row * D : (float*)(p.ws + WS_XCTX) + (size_t)(row - MLAT) * D;
}

DI void convert_tile(const float* src, int ld_src, u16* dst, int ld_dst, int k0, int nsrc0, int ndst0) {
  float* t = (float*)g_lds;
  const int tid = otid();
#pragma unroll
  for (int it = 0; it < 2; ++it) {
    int idx = tid + it * 512; int i = idx >> 4, j4 = idx & 15;
    float4 v = *(const float4*)(src + (size_t)(k0 + i) * ld_src + nsrc0 + j4 * 4);
    t[(j4 * 4 + 0) * 65 + i] = v.x; t[(j4 * 4 + 1) * 65 + i] = v.y; t[(j4 * 4 + 2) * 65 + i] = v.z; t[(j4 * 4 + 3) * 65 + i] = v.w;
  }
  __syncthreads();
  int n = tid >> 3, kq = tid & 7;
  const float* r = t + n * 65 + kq * 8;
  uint4 o; o.x = pack2(r[0], r[1]); o.y = pack2(r[2], r[3]); o.z = pack2(r[4], r[5]); o.w = pack2(r[6], r[7]);
  *(uint4*)(dst + (size_t)(ndst0 + n) * ld_dst + k0 + kq * 8) = o;
  __syncthreads();
}

__device__ void phase_setup(const Params& p) {
  const int tid = otid();
  const int N_FFI = 8 * 16 * 88, N_FFO = 8 * 44 * 16, N_EVI = 2 * 16 * 42, N_EVO = 2 * 256, N_ODI = 2 * 16 * 24, N_ODO = 2 * 256;
  const int total = N_FFI + N_FFO + N_EVI + N_EVO + N_ODI + N_ODO;
  for (int it = obid(); it < total; it += gridDim.x) {
    int t = it;
    if (t < N_FFI) {
      int m = t / 1408, r = t % 1408; int kt = r & 15, nt = r >> 4;
      int nd = nt * 64; int t256 = nd >> 8, half = (nd >> 7) & 1, c0 = nd & 127;
      convert_tile(p.in[6] + (size_t)m * 1024 * 5632, 5632, (u16*)(p.ws + WS_FFI) + (size_t)m * 5632 * 1024, 1024, kt * 64, half * 2816 + t256 * 128 + c0, nd);
      continue;
    }
    t -= N_FFI;
    if (t < N_FFO) {
      int m = t / 704, r = t % 704; int kt = r % 44, nt = r / 44;
      convert_tile(p.in[7] + (size_t)m * 2816 * 1024, 1024, (u16*)(p.ws + WS_FFO) + (size_t)m * 1024 * 2816, 2816, kt * 64, nt * 64, nt * 64);
      continue;
    }
    t -= N_FFO;
    if (t < N_EVI) {
      int m = t / 672, r = t % 672; int kt = r & 15, nt = r >> 4;
      convert_tile(p.in[8] + (size_t)m * 1024 * EVC, EVC, (u16*)(p.ws + WS_EVI) + (size_t)m * EVCP * 1024, 1024, kt * 64, nt * 64, nt * 64);
      continue;
    }
    t -= N_EVI;
    if (t < N_EVO) {
      int m = t / 256, r = t % 256; int kt = r & 15, nt = r >> 4;
      convert_tile(p.in[9] + (size_t)m * 1024 * 1024, 1024, (u16*)(p.ws + WS_EVO) + (size_t)m * 1024 * 1024, 1024, kt * 64, nt * 64, nt * 64);
      continue;
    }
    t -= N_EVO;
    if (t < N_ODI) {
      int m = t / 384, r = t % 384; int kt = r & 15, nt = r >> 4;
      convert_tile(p.in[23] + (size_t)m * 1024 * ODC, ODC, (u16*)(p.ws + WS_ODI) + (size_t)m * ODC * 1024, 1024, kt * 64, nt * 64, nt * 64);
      continue;
    }
    t -= N_ODI;
    {
      int m = t / 256, r = t % 256; int kt = r & 15, nt = r >> 4;
      convert_tile(p.in[24] + (size_t)m * 1024 * 1024, 1024, (u16*)(p.ws + WS_ODO) + (size_t)m * 1024 * 1024, 1024, kt * 64, nt * 64, nt * 64);
    }
  }
  for (int i = obid() * 512 + tid; i < 2 * 128 * 1024 / 8; i += gridDim.x * 512) {
    int m = i / (128 * 128), r = i % (128 * 128);
    *(uint4*)((u16*)(p.ws + WS_EVI) + (size_t)m * EVCP * 1024 + (size_t)EVC * 1024 + (size_t)r * 8) = make_uint4(0, 0, 0, 0);
  }
  {
    const float4* xs = (const float4*)p.in[0]; float4* xd = (float4*)p.out;
    for (size_t i = (size_t)obid() * 512 + tid; i < (size_t)MLAT * D / 4; i += (size_t)gridDim.x * 512) xd[i] = xs[i];
    const float4* cs = (const float4*)p.in[2]; float4* cd = (float4*)(p.ws + WS_XCTX);
    for (size_t i = (size_t)obid() * 512 + tid; i < (size_t)MCTX * D / 4; i += (size_t)gridDim.x * 512) cd[i] = cs[i];
  }
  if (obid() == 0 && tid < 64) ((unsigned*)(p.ws + WS_CNT))[tid] = 0u;
}

__device__ void phase_mod(const Params& p) {
  const int tid = otid();
  float* sc = (float*)g_lds;
  float* red = sc + 9 * 1024;
  for (int i = tid; i < 9 * 1024; i += 512) {
    int e = i >> 10, k = i & 1023; float v = e < 8 ? p.in[1][e * 1024 + k] : p.in[3][k];
    sc[i] = v / (1.f + __expf(-v));
  }
  __syncthreads();
  float* mod = (float*)(p.ws + WS_MOD);
  for (int tile = obid(); tile < 576; tile += gridDim.x) {
    int l = tile / 144, cgp = tile % 144;
    int cl = tid & 63, kg = tid >> 6;
    const float* w = p.in[4] + (size_t)l * 1024 * 9216 + cgp * 64 + cl;
    float acc[9];
#pragma unroll
    for (int e = 0; e < 9; ++e) acc[e] = 0.f;
    for (int k = kg * 128; k < kg * 128 + 128; ++k) {
      float wv = w[(size_t)k * 9216];
#pragma unroll
      for (int e = 0; e < 9; ++e) acc[e] += sc[e * 1024 + k] * wv;
    }
#pragma unroll
    for (int e = 0; e < 9; ++e) red[(kg * 9 + e) * 64 + cl] = acc[e];
    __syncthreads();
    for (int o = tid; o < 576; o += 512) {
      int e = o >> 6, cc = o & 63; float s = 0.f;
#pragma unroll
      for (int k2 = 0; k2 < 8; ++k2) s += red[(k2 * 9 + e) * 64 + cc];
      mod[(size_t)(l * 9 + e) * 9216 + cgp * 64 + cc] = s + p.in[5][l * 9216 + cgp * 64 + cc];
    }
    __syncthreads();
  }
}

__device__ void phase_prep(const Params& p, int l, int sh, int nrows) {
  const int tid_ = otid(); const int lane = tid_ & 63, wave = tid_ >> 6;
  u16* H = (u16*)(p.ws + WS_H);
  const float* modl = (const float*)(p.ws + WS_MOD) + (size_t)l * 9 * 9216;
  for (int row = obid() * 16 + wave; row < nrows; row += gridDim.x * 16) {
    const float4* xr0 = (const float4*)xrow(p, row);
    const float4* xr1 = (const float4*)xrow(p, row + 8);
    int e = row < MLAT ? row >> 12 : 8;
    const float* m = modl + (size_t)e * 9216;
    float4 v[2][4]; float ss0 = 0.f, ss1 = 0.f;
#pragma unroll
    for (int q = 0; q < 4; ++q) { v[0][q] = xr0[lane + q * 64]; v[1][q] = xr1[lane + q * 64]; }
#pragma unroll
    for (int q = 0; q < 4; ++q) {
      ss0 += v[0][q].x * v[0][q].x + v[0][q].y * v[0][q].y + v[0][q].z * v[0][q].z + v[0][q].w * v[0][q].w;
      ss1 += v[1][q].x * v[1][q].x + v[1][q].y * v[1][q].y + v[1][q].z * v[1][q].z + v[1][q].w * v[1][q].w;
    }
    ss0 = wave_sum(ss0); ss1 = wave_sum(ss1);
    const float rstd0 = rsqrtf(ss0 * (1.f / 1024.f) + 1e-6f), rstd1 = rsqrtf(ss1 * (1.f / 1024.f) + 1e-6f);
#pragma unroll
    for (int q = 0; q < 4; ++q) {
      int col = (lane + q * 64) * 4;
      float4 s4 = *(const float4*)(m + sh * 1024 + col), c4 = *(const float4*)(m + (sh + 1) * 1024 + col);
      uint2 o;
      o.x = pack2(v[0][q].x * rstd0 * (1.f + c4.x) + s4.x, v[0][q].y * rstd0 * (1.f + c4.y) + s4.y);
      o.y = pack2(v[0][q].z * rstd0 * (1.f + c4.z) + s4.z, v[0][q].w * rstd0 * (1.f + c4.w) + s4.w);
      *(uint2*)(H + (size_t)row * D + col) = o;
      o.x = pack2(v[1][q].x * rstd1 * (1.f + c4.x) + s4.x, v[1][q].y * rstd1 * (1.f + c4.y) + s4.y);
      o.y = pack2(v[1][q].z * rstd1 * (1.f + c4.z) + s4.z, v[1][q].w * rstd1 * (1.f + c4.w) + s4.w);
      *(uint2*)(H + (size_t)(row + 8) * D + col) = o;
    }
  }
}

namespace pg8 {
#define PG8_LAS __attribute__((address_space(3)))
typedef unsigned short bf16_t;
typedef unsigned u32x4 __attribute__((ext_vector_type(4)));
constexpr int BM = 256, BK = 64, HALF = 128, HTB = HALF * BK * 2, STAGE_BYTES = 8 * HTB, NXCD = 8, WGM = 8;
__host__ __device__ __forceinline__ int lds_byte(int r, int c) { const int st = (r >> 4) * 2 + (c >> 5), rr = r & 15, cc = c & 31, ob = rr * 64 + cc * 2; return st * 1024 + (ob ^ (((ob >> 9) & 1) << 5)); }
__host__ __device__ __forceinline__ void stage_rc(int b, int& R, int& C) { const int st = b / 1024, sb = b % 1024, swz = sb ^ (((sb >> 9) & 1) << 5); R = (st >> 1) * 16 + swz / 64; C = (st & 1) * 32 + (swz % 64) / 2; }
__host__ __device__ __forceinline__ int perm32(int rho) { const int n = rho >> 4, i = rho & 15; return 8 * (i >> 2) + 4 * n + (i & 3); }
struct Unit { int pm, pn; };
struct Gemm { const bf16_t* A; const bf16_t* Bt; int M, N, K; };
struct StaticOrder {
    int nM, nN, nwg, G, c;
    __host__ __device__ void init(int M, int N, int G_, int c_) { nM = M / BM; nN = N / BM; nwg = nM * nN; G = G_; c = c_; }
    __host__ __device__ bool next(int i, Unit& u) const {
        const long L = (long)i * G + c; if (L >= nwg) return false;
        int wgid = (int)L; { const int q = nwg / NXCD, r = nwg % NXCD, xcd = wgid % NXCD, off = wgid / NXCD; wgid = (xcd < r ? xcd * (q + 1) : r * (q + 1) + (xcd - r) * q) + off; }
        const int nig = WGM * nN, gid = wgid / nig, fm = gid * WGM, gsz = (nM - fm) < WGM ? (nM - fm) : WGM;
        u.pm = fm + ((wgid % nig) % gsz); u.pn = (wgid % nig) / gsz; return true;
    }
    __device__ __forceinline__ void a_ready(const Unit&) const {}
    __device__ __forceinline__ void done(const Unit&) const {}
};
template <class Epi, class Sched, bool STAMP = false>
__device__ __forceinline__ void gemm_phase(PG8_LAS unsigned char* lds, const Gemm g, const Sched& S, const Epi& E, unsigned long long* stamps) {
    const int tid = otid(), wid = __builtin_amdgcn_readfirstlane(tid >> 6), lane = tid & 63, wr = wid >> 2, wc = wid & 3, fr = lane & 15, fq = lane >> 4;
    const int K = g.K, nt = K / BK;
    int ts_lo = 0, ts_hi = 0, nts = 0; const unsigned long long rt_entry = STAMP ? (unsigned long long)wall_clock64() : 0ull;
#define PG8_STAMP() do { if (STAMP && wid == 0 && nts < 64) { const unsigned long long _c = (unsigned long long)clock64(); \
        ts_lo = (lane == nts) ? (int)(unsigned)_c : ts_lo; ts_hi = (lane == nts) ? (int)(unsigned)(_c >> 32) : ts_hi; ++nts; } } while (0)
    PG8_STAMP();
    unsigned voffA[2], voffB[2];
#pragma unroll
    for (int i = 0; i < 2; ++i) { int R, C; stage_rc(tid * 16 + i * 8192, R, C); const int Rb = Epi::PERM ? ((R & ~31) + perm32(R & 31)) : R;
        voffA[i] = (unsigned)(R * K + C) * 2u; voffB[i] = (unsigned)(Rb * K + C) * 2u; }
    const size_t kstep = (size_t)(BK * 2);
    const size_t hstep = (size_t)HALF * K * 2;
    const size_t tstep = 2 * hstep;
    const unsigned ldsw = (unsigned)wid * 1024u;
    const int aoff = lds_byte(wr * 64 + fr, fq * 8), boff = lds_byte(wc * 32 + fr, fq * 8);
#define PG8_SA(b, h) (((b) * 2 + (h)) * HTB)
#define PG8_SB(b, h) ((4 + (b) * 2 + (h)) * HTB)
#define PG8_STAGE(bufoff, gbase, voff) do { _Pragma("unroll") for (int _i = 0; _i < 2; ++_i) \
        __builtin_amdgcn_global_load_lds((const unsigned*)((const char*)(gbase) + (voff)[_i]), (PG8_LAS unsigned*)(lds + (bufoff) + ldsw + _i * 8192), 16, 0, 0); } while (0)
#define PG8_LDA(dst, b, h) do { _Pragma("unroll") for (int m = 0; m < 4; ++m) _Pragma("unroll") for (int k = 0; k < 2; ++k) dst[m][k] = *(const PG8_LAS bf16x8*)(lds + PG8_SA(b, h) + aoff + m * 2048 + k * 1024); } while (0)
#define PG8_LDB(dst, b, h) do { _Pragma("unroll") for (int n = 0; n < 2; ++n) _Pragma("unroll") for (int k = 0; k < 2; ++k) dst[n][k] = *(const PG8_LAS bf16x8*)(lds + PG8_SB(b, h) + boff + n * 2048 + k * 1024); } while (0)
#define PG8_MMA(ai, bj, At, Bt) do { __builtin_amdgcn_s_setprio(1); _Pragma("unroll") for (int m = 0; m < 4; ++m) _Pragma("unroll") for (int n = 0; n < 2; ++n) _Pragma("unroll") for (int k = 0; k < 2; ++k) \
        acc[ai][bj][m][n] = __builtin_amdgcn_mfma_f32_16x16x32_bf16(Bt[n][k], At[m][k], acc[ai][bj][m][n], 0, 0, 0); __builtin_amdgcn_s_setprio(0); } while (0)
#define PG8_WAIT_V(n) asm volatile("s_waitcnt vmcnt(" #n ")" ::: "memory")
#define PG8_WAIT_L(n) asm volatile("s_waitcnt lgkmcnt(" #n ")" ::: "memory")
#define PG8_BAR __builtin_amdgcn_s_barrier()
#define PG8_SCHED __builtin_amdgcn_sched_barrier(0)
    Unit cur, nxt; int ui = 0;
    if (!S.next(0, cur)) return;
    f32x4 acc[2][2][4][2];
#pragma unroll
    for (int a = 0; a < 2; ++a)
#pragma unroll
        for (int b = 0; b < 2; ++b)
#pragma unroll
            for (int m = 0; m < 4; ++m)
#pragma unroll
                for (int n = 0; n < 2; ++n) acc[a][b][m][n] = (f32x4){0.f, 0.f, 0.f, 0.f};
    bf16x8 At[4][2], B0[2][2], B1[2][2];
    const char* cA = (const char*)g.A + (size_t)cur.pm * tstep; const char* cB = (const char*)g.Bt + (size_t)cur.pn * tstep;
    S.a_ready(cur);
    PG8_STAGE(PG8_SB(0, 0), cB, voffB); PG8_STAGE(PG8_SA(0, 0), cA, voffA); PG8_STAGE(PG8_SB(0, 1), cB + hstep, voffB); PG8_STAGE(PG8_SA(0, 1), cA + hstep, voffA);
    if (wr == 1) PG8_BAR;
    PG8_WAIT_V(4); PG8_BAR;
    PG8_STAGE(PG8_SB(1, 0), cB + kstep, voffB); PG8_STAGE(PG8_SA(1, 0), cA + kstep, voffA); PG8_STAGE(PG8_SB(1, 1), cB + hstep + kstep, voffB);
    PG8_WAIT_V(6); PG8_BAR;
    PG8_STAMP();
    for (;;) {
        const bool has_next = S.next(ui + 1, nxt);
        const char* nA = has_next ? (const char*)g.A + (size_t)nxt.pm * tstep : cA; const char* nB = has_next ? (const char*)g.Bt + (size_t)nxt.pn * tstep : cB;
        for (int t = 0; t < nt; t += 2) {
            const bool last = (t == nt - 2);
            const char* a1 = cA + (size_t)(t + 1) * kstep;
            const char* a2 = last ? nA : cA + (size_t)(t + 2) * kstep; const char* b2 = last ? nB : cB + (size_t)(t + 2) * kstep;
            const char* a3 = a2 + kstep; const char* b3 = b2 + kstep;
            if (last && has_next) S.a_ready(nxt);
            PG8_LDB(B0, 0, 0); PG8_SCHED; PG8_LDA(At, 0, 0); PG8_STAGE(PG8_SA(1, 1), a1 + hstep, voffA);
            PG8_WAIT_L(8); PG8_BAR; PG8_WAIT_L(0); PG8_MMA(0, 0, At, B0); PG8_BAR; PG8_SCHED;
            PG8_LDB(B1, 0, 1); PG8_STAGE(PG8_SB(0, 0), b2, voffB);
            PG8_BAR; PG8_WAIT_L(0); PG8_MMA(0, 1, At, B1); PG8_BAR;
            PG8_LDA(At, 0, 1); PG8_STAGE(PG8_SA(0, 0), a2, voffA);
            PG8_BAR; PG8_WAIT_L(0); PG8_MMA(1, 0, At, B0); PG8_BAR; PG8_SCHED;
            PG8_STAGE(PG8_SB(0, 1), b2 + hstep, voffB);
            PG8_WAIT_V(6); PG8_BAR; PG8_MMA(1, 1, At, B1); PG8_BAR;
            PG8_LDB(B0, 1, 0); PG8_SCHED; PG8_LDA(At, 1, 0); PG8_STAGE(PG8_SA(0, 1), a2 + hstep, voffA);
            PG8_WAIT_L(8); PG8_BAR; PG8_WAIT_L(0); PG8_MMA(0, 0, At, B0); PG8_BAR; PG8_SCHED;
            PG8_LDB(B1, 1, 1); PG8_STAGE(PG8_SB(1, 0), b3, voffB);
            PG8_BAR; PG8_WAIT_L(0); PG8_MMA(0, 1, At, B1); PG8_BAR;
            PG8_LDA(At, 1, 1); PG8_STAGE(PG8_SA(1, 0), a3, voffA);
            PG8_BAR; PG8_WAIT_L(0); PG8_MMA(1, 0, At, B0); PG8_BAR; PG8_SCHED;
            PG8_STAGE(PG8_SB(1, 1), b3 + hstep, voffB);
            PG8_WAIT_V(6); PG8_BAR; PG8_MMA(1, 1, At, B1); PG8_BAR;
        }
        PG8_STAMP();
        if constexpr (!Epi::AFTER_DRAIN) { E(acc, cur, wr, wc, fr, fq); S.done(cur); }
        PG8_STAMP();
        if (!has_next) break;
#pragma unroll
        for (int a = 0; a < 2; ++a)
#pragma unroll
            for (int b = 0; b < 2; ++b)
#pragma unroll
                for (int m = 0; m < 4; ++m)
#pragma unroll
                    for (int n = 0; n < 2; ++n) acc[a][b][m][n] = (f32x4){0.f, 0.f, 0.f, 0.f};
        cur = nxt; cA = nA; cB = nB; ++ui;
    }
    PG8_WAIT_V(0);
    if (wr == 0) PG8_BAR;
    PG8_BAR;
    if constexpr (Epi::AFTER_DRAIN) { E.fused(acc, cur, wr, wc, fr, fq, lds, wid, lane); S.done(cur); }
    PG8_STAMP();
    if (STAMP && wid == 0) { stamps[lane] = lane < nts ? (((unsigned long long)(unsigned)ts_hi << 32) | (unsigned)ts_lo) : 0ull;
        if (lane == 62) stamps[62] = rt_entry; if (lane == 63) stamps[63] = (unsigned long long)wall_clock64(); }
#undef PG8_STAMP
#undef PG8_SA
#undef PG8_SB
#undef PG8_STAGE
#undef PG8_LDA
#undef PG8_LDB
#undef PG8_MMA
#undef PG8_WAIT_V
#undef PG8_WAIT_L
#undef PG8_BAR
#undef PG8_SCHED
}
}

struct EpiAct {
  static constexpr bool PERM = true, AFTER_DRAIN = false;
  u16* act;
  DI void operator()(const f32x4 (&acc)[2][2][4][2], const pg8::Unit& u, int wr, int wc, int fr, int fq) const {
    const int row0 = u.pm * 256 + wr * 64 + fr, col0 = u.pn * 128 + wc * 32 + 8 * fq;
#pragma unroll
    for (int ai = 0; ai < 2; ++ai)
#pragma unroll
      for (int m = 0; m < 4; ++m) {
        u16* rowp = act + (size_t)(row0 + ai * 128 + m * 16) * DFF + col0;
        float o[8];
#pragma unroll
        for (int n = 0; n < 2; ++n)
#pragma unroll
          for (int j = 0; j < 4; ++j) { float g = acc[ai][0][m][n][j], up = acc[ai][1][m][n][j]; o[n * 4 + j] = g * up * __builtin_amdgcn_rcpf(1.f + __builtin_amdgcn_exp2f(-1.4426950408889634f * g)); }
        uint4 w; w.x = pack2(o[0], o[1]); w.y = pack2(o[2], o[3]); w.z = pack2(o[4], o[5]); w.w = pack2(o[6], o[7]);
        *(uint4*)rowp = w;
      }
  }
};
struct EpiRes {
  static constexpr bool PERM = false, AFTER_DRAIN = false;
  float* xlat; float* xctx; const float* modl; int gidx; float coef;
  DI void operator()(const f32x4 (&acc)[2][2][4][2], const pg8::Unit& u, int wr, int wc, int fr, int fq) const {
    const int brow = u.pm * 256;
    const int e = brow < MLAT ? brow >> 12 : 8;
    float* xb = (brow < MLAT ? xlat + (size_t)brow * D : xctx + (size_t)(brow - MLAT) * D) + (size_t)(wr * 64 + fr) * D;
    const int col0 = u.pn * 256 + wc * 32 + 4 * fq;
    const float* mg = modl + (size_t)e * 9216 + gidx * 1024 + col0;
    f32x4 gm[2][2];
#pragma unroll
    for (int bj = 0; bj < 2; ++bj)
#pragma unroll
      for (int n = 0; n < 2; ++n) gm[bj][n] = *(const f32x4*)(mg + bj * 128 + n * 16) * coef;
#pragma unroll
    for (int ai = 0; ai < 2; ++ai)
#pragma unroll
      for (int m = 0; m < 4; ++m) {
        float* rowp = xb + (size_t)(ai * 128 + m * 16) * D + col0;
#pragma unroll
        for (int bj = 0; bj < 2; ++bj)
#pragma unroll
          for (int n = 0; n < 2; ++n) {
            f32x4* xp = (f32x4*)(rowp + bj * 128 + n * 16);
            *xp = *xp + gm[bj][n] * acc[ai][bj][m][n];
          }
      }
  }
};
struct EpiP {
  static constexpr bool PERM = true, AFTER_DRAIN = false;
  u16* P; int ld; int nvalid; float one;
  DI void operator()(const f32x4 (&acc)[2][2][4][2], const pg8::Unit& u, int wr, int wc, int fr, int fq) const {
    const int row0 = u.pm * 256 + wr * 64 + fr, col0 = u.pn * 256 + wc * 32 + 8 * fq;
#pragma unroll
    for (int ai = 0; ai < 2; ++ai)
#pragma unroll
      for (int m = 0; m < 4; ++m) {
        u16* rowp = P + (size_t)(row0 + ai * 128 + m * 16) * ld + col0;
#pragma unroll
        for (int bj = 0; bj < 2; ++bj) {
          if (col0 + bj * 128 < nvalid) {
            const f32x4 v0 = acc[ai][bj][m][0] * one, v1 = acc[ai][bj][m][1] * one;
            uint4 w; w.x = pack2(v0[0], v0[1]); w.y = pack2(v0[2], v0[3]); w.z = pack2(v1[0], v1[1]); w.w = pack2(v1[2], v1[3]);
            *(uint4*)(rowp + bj * 128) = w;
          }
        }
      }
  }
};

template <class Epi>
DI void gemm_phase(const u16* A, const u16* Bt, int Mrows, int N, int K, const Epi& epi) {
  pg8::Gemm g{A, Bt, Mrows, N, K};
  pg8::StaticOrder S; S.init(Mrows, N, (int)gridDim.x, obid());
  pg8::gemm_phase<Epi, pg8::StaticOrder, false>((PG8_LAS unsigned char*)g_lds, g, S, epi, nullptr);
}

template <bool EVEN>
__device__ void phase_feat_t(const Params& p, int l) {
  const int tid = otid(), lane = tid & 63, wave = tid >> 6;
  const int e = l >> 1;
  constexpr int NQ = EVEN ? 8 : 16, NKV = EVEN ? 2 : 4, ld = EVEN ? EVC : ODC;
  constexpr int nch = NQ + 2 * NKV, NIT = nch / 2;
  const u16* P = (const u16*)(p.ws + WS_ACT);
  u16* Q = (u16*)(p.ws + WS_Q); u16* Kd = (u16*)(p.ws + WS_K); u16* Vt = (u16*)(p.ws + WS_VT);
  u16* vts = (u16*)g_lds;
  const int i = lane & 31;
  const float qg0 = p.in[10][e * 64 + 2 * i], qg1 = p.in[10][e * 64 + 2 * i + 1];
  const float kg0 = p.in[11][e * 64 + 2 * i], kg1 = p.in[11][e * 64 + 2 * i + 1];
  const float invf = exp2f(-(float)(i & 15) * (13.287712379549449f / 16.f));
  for (int g = obid(); g < MTOT / 64; g += gridDim.x) {
    const int row0 = g * 64; const bool lat = row0 < MLAT;
    int b, tok0;
    if (lat) { b = row0 >> 12; tok0 = row0 & 4095; } else { int r = row0 - MLAT; b = r >> 8; tok0 = 4096 + (r & 255); }
#pragma unroll 2
    for (int tj = 0; tj < 8; ++tj) {
      const int ti = wave + 8 * tj;
      const int row = row0 + ti, tok = tok0 + ti;
      unsigned pv[NIT];
      const u16* prow = P + (size_t)row * ld + (lane >> 5) * 64 + 2 * i;
#pragma unroll
      for (int it = 0; it < NIT; ++it) pv[it] = *(const unsigned*)(prow + it * 128);
      float cs = 1.f, sn = 0.f;
      if (lat) { float pos = (i < 16) ? (float)(tok >> 6) : (float)(tok & 63); float ang = pos * invf; cs = __cosf(ang); sn = __sinf(ang); }
#pragma unroll
      for (int it = 0; it < NIT; ++it) {
        const int ch = it * 2 + (lane >> 5);
        float x0 = bf2f((u16)(pv[it] & 0xffff)), x1 = bf2f((u16)(pv[it] >> 16));
        const bool isq = it * 2 < NQ, isk = !isq && it * 2 < NQ + NKV;
        if (EVEN && (isq || isk)) {
          float ss = row_sum16(x0 * x0 + x1 * x1);
          ss += __shfl_xor(ss, 16);
          float r = rsqrtf(ss * (1.f / 64.f) + 1e-6f);
          x0 *= r * (isq ? qg0 : kg0); x1 *= r * (isq ? qg1 : kg1);
        }
        if (isq || isk) {
          float y0 = x0 * cs - x1 * sn, y1 = x0 * sn + x1 * cs;
          if (isq) {
            const float sc = 0.125f * 1.4426950408889634f;
            *(unsigned*)(Q + ((size_t)(b * NQ + ch) * NTOK + tok) * 64 + 2 * i) = pack2(y0 * sc, y1 * sc);
          } else {
            *(unsigned*)(Kd + ((size_t)(b * NKV + (ch - NQ)) * NTOK + tok) * 64 + 2 * i) = pack2(y0, y1);
          }
        } else {
          int vr = (ch - NQ - NKV) * 64 + 2 * i;
          vts[vr * 72 + ti] = f2bf(x0); vts[(vr + 1) * 72 + ti] = f2bf(x1);
        }
      }
    }
    __syncthreads();
    for (int idx = tid; idx < NKV * 64 * 8; idx += 512) {
      int r = idx >> 3, seg = idx & 7; int kvh = r >> 6, d = r & 63;
      uint4 val = *(const uint4*)&vts[r * 72 + seg * 8];
      *(uint4*)(Vt + ((size_t)(b * NKV + kvh) * 64 + d) * NTOK + tok0 + seg * 8) = val;
    }
    __syncthreads();
  }
}
__device__ void phase_feat(const Params& p, int l) {
  if (l & 1) phase_feat_t<false>(p, l); else phase_feat_t<true>(p, l);
}

DI bf16x8 pack8(const f32x16& x, int s) {
  uint4 r;
  r.x = pack2(x[8 * s + 0], x[8 * s + 1]); r.y = pack2(x[8 * s + 2], x[8 * s + 3]);
  r.z = pack2(x[8 * s + 4], x[8 * s + 5]); r.w = pack2(x[8 * s + 6], x[8 * s + 7]);
  return __builtin_bit_cast(bf16x8, r);
}

__device__ void attn_item(const Params& p, int NQ, int NKV, int b, int kvh, int q0, bool windowed, bool has_sink, const float* sinkp) {
  const int tid = otid(), lane = tid & 63, wave = tid >> 6, r = lane & 31, h = lane >> 5;
  const u16* Q = (const u16*)(p.ws + WS_Q); const u16* Kd = (const u16*)(p.ws + WS_K); const u16* Vt = (const u16*)(p.ws + WS_VT);
  u16* O = (u16*)(p.ws + WS_H);
  const int head = kvh * 4 + (wave >> 1);
  const int qtok = q0 + (wave & 1) * 32 + r;
  const bool is_ctx = q0 >= 4096;
  const u16* qp = Q + ((size_t)(b * NQ + head) * NTOK + qtok) * 64;
  bf16x8 qf[4];
#pragma unroll
  for (int kk = 0; kk < 4; ++kk) qf[kk] = *(const bf16x8*)(qp + kk * 16 + h * 8);
  const u16* Kb = Kd + (size_t)(b * NKV + kvh) * NTOK * 64;
  const u16* Vb = Vt + (size_t)(b * NKV + kvh) * 64 * NTOK;
  int nt, nwin = 0, wlo = 0;
  if (is_ctx) { nt = 4; wlo = 4096; nwin = 0; }
  else if (windowed) { wlo = q0 - 128 < 128 ? 128 : q0 - 128; int whi = q0 + 192 > 4096 ? 4096 : q0 + 192; nwin = (whi - wlo) >> 6; nt = nwin + 4; }
  else { nt = 68; }
#define KSTART(it) (is_ctx ? 4096 + (it) * 64 : (windowed ? ((it) < nwin ? wlo + (it) * 64 : 4096 + ((it) - nwin) * 64) : (it) * 64))
  u16* Ks = (u16*)g_lds; u16* Vs = Ks + 2 * 64 * 72;
  const int lrow = tid >> 3, lseg = tid & 7;
  uint4 kreg, vreg;
  { int ks = KSTART(0);
    kreg = *(const uint4*)(Kb + (size_t)(ks + lrow) * 64 + lseg * 8);
    vreg = *(const uint4*)(Vb + (size_t)lrow * NTOK + ks + lseg * 8);
    *(uint4*)&Ks[lrow * 72 + lseg * 8] = kreg; *(uint4*)&Vs[lrow * 72 + lseg * 8] = vreg; }
  __syncthreads();
  f32x16 ot[2];
#pragma unroll
  for (int i = 0; i < 16; ++i) { ot[0][i] = 0.f; ot[1][i] = 0.f; }
  float mrun = -1e30f, lsum = 0.f;
  if (windowed && !is_ctx) { int nph = qtok + 129 - 4096; if (nph > 0) { mrun = 0.f; lsum = (float)nph; } }
  for (int it = 0; it < nt; ++it) {
    const int cur = it & 1;
    const u16* Kc = Ks + cur * 64 * 72; const u16* Vc = Vs + cur * 64 * 72;
    if (it + 1 < nt) { int ks = KSTART(it + 1);
      kreg = *(const uint4*)(Kb + (size_t)(ks + lrow) * 64 + lseg * 8);
      vreg = *(const uint4*)(Vb + (size_t)lrow * NTOK + ks + lseg * 8); }
    f32x16 st[2];
#pragma unroll
    for (int kt = 0; kt < 2; ++kt) {
#pragma unroll
      for (int i = 0; i < 16; ++i) st[kt][i] = 0.f;
#pragma unroll
      for (int kk = 0; kk < 4; ++kk) {
        bf16x8 kf = *(const bf16x8*)&Kc[(kt * 32 + r) * 72 + kk * 16 + h * 8];
        st[kt] = __builtin_amdgcn_mfma_f32_32x32x16_bf16(kf, qf[kk], st[kt], 0, 0, 0);
      }
    }
    if (windowed && it < nwin) {
      const int ks = KSTART(it);
#pragma unroll
      for (int kt = 0; kt < 2; ++kt)
#pragma unroll
        for (int i = 0; i < 16; ++i) {
          int key = ks + kt * 32 + (i & 3) + 8 * (i >> 2) + 4 * h;
          int dlt = key - qtok; dlt = dlt < 0 ? -dlt : dlt;
          if (dlt > 128) st[kt][i] = -1e30f;
        }
    }
    float mx = -1e30f;
#pragma unroll
    for (int kt = 0; kt < 2; ++kt)
#pragma unroll
      for (int i = 0; i < 16; ++i) mx = fmaxf(mx, st[kt][i]);
    mx = fmaxf(mx, __shfl_xor(mx, 32));
    const float mnew = fmaxf(mrun, mx);
    const float alpha = __builtin_amdgcn_exp2f(mrun - mnew);
    float rs = 0.f;
#pragma unroll
    for (int kt = 0; kt < 2; ++kt)
#pragma unroll
      for (int i = 0; i < 16; ++i) {
        float sv = st[kt][i];
        float pe = sv <= -1e29f ? 0.f : __builtin_amdgcn_exp2f(sv - mnew);
        st[kt][i] = pe; rs += pe;
      }
    rs += __shfl_xor(rs, 32);
    lsum = lsum * alpha + rs;
    mrun = mnew;
#pragma unroll
    for (int i = 0; i < 16; ++i) { ot[0][i] *= alpha; ot[1][i] *= alpha; }
#pragma unroll
    for (int kt = 0; kt < 2; ++kt)
#pragma unroll
      for (int s = 0; s < 2; ++s) {
        bf16x8 pf = pack8(st[kt], s);
#pragma unroll
        for (int db = 0; db < 2; ++db) {
          const u16* vp = &Vc[(db * 32 + r) * 72 + kt * 32 + 16 * s + 4 * h];
          uint2 v0 = *(const uint2*)vp, v1 = *(const uint2*)(vp + 8);
          uint4 vv = make_uint4(v0.x, v0.y, v1.x, v1.y);
          bf16x8 vf = __builtin_bit_cast(bf16x8, vv);
          ot[db] = __builtin_amdgcn_mfma_f32_32x32x16_bf16(vf, pf, ot[db], 0, 0, 0);
        }
      }
    if (it + 1 < nt) {
      u16* Kn = Ks + (cur ^ 1) * 64 * 72; u16* Vn = Vs + (cur ^ 1) * 64 * 72;
      *(uint4*)&Kn[lrow * 72 + lseg * 8] = kreg; *(uint4*)&Vn[lrow * 72 + lseg * 8] = vreg;
    }
    __syncthreads();
  }
#undef KSTART
  if (has_sink) lsum += __builtin_amdgcn_exp2f(sinkp[head] * 1.4426950408889634f - mrun);
  const float inv = 1.f / lsum;
  const size_t orow = is_ctx ? (size_t)MLAT + b * 256 + (qtok - 4096) : (size_t)b * 4096 + qtok;
  u16* op = O + orow * D + head * 64;
#pragma unroll
  for (int db = 0; db < 2; ++db)
#pragma unroll
    for (int g = 0; g < 4; ++g) {
      uint2 o;
      o.x = pack2(ot[db][4 * g + 0] * inv, ot[db][4 * g + 1] * inv);
      o.y = pack2(ot[db][4 * g + 2] * inv, ot[db][4 * g + 3] * inv);
      *(uint2*)(op + db * 32 + 8 * g + 4 * h) = o;
    }
}

DI void lbar() { asm volatile("s_waitcnt lgkmcnt(0)\n\ts_barrier" ::: "memory"); }
DI void lbar1() { asm volatile("s_waitcnt lgkmcnt(1)\n\ts_barrier" ::: "memory"); }
DI float fast_tanh(float x) { float e = __expf(2.f * x); return 1.f - 2.f / (e + 1.f); }
DI float dot16(const f32x4 (&s)[4], const f32x4& a0, const f32x4& a1, const f32x4& a2, const f32x4& a3) {
  f32x4 t = s[0] * a0; t += s[1] * a1; t += s[2] * a2; t += s[3] * a3;
  return (t[0] + t[1]) + (t[2] + t[3]);
}
__device__ void scan_chain(const Params& p, int e, int chain, int rep) {
  const int tid = otid(), lane = tid & 63, wave = __builtin_amdgcn_readfirstlane(tid >> 6);
  const int b = chain >> 4, h = (chain >> 1) & 7, d = chain & 1;
  const u16* P = (const u16*)(p.ws + WS_ACT);
  u16* Y = (u16*)(p.ws + WS_Y);
  float* sb0 = (float*)g_lds;
  float* bg0 = sb0 + 2 * 6144;
  float* part = bg0 + 2 * 128;
  float* yp0 = part + 512;
  float* tk = yp0 + 2 * 4096;
  u16* ttwb = (u16*)(tk + 1024);
  u16* talb = ttwb + 16 * 72;
  float* mus = tk + 1024 + 1152;
  const float* mu = p.in[12] + (size_t)e * 2 * 1920;
  auto chunk_geo = [&](int ci, int& t0, int& T, size_t& rowbase) {
    if (ci < 16) { T = 256; rowbase = (size_t)MLAT + b * 256; t0 = d ? 240 - ci * 16 : ci * 16; }
    else { T = 4096; rowbase = (size_t)b * 4096; int cj = ci - 16; t0 = d ? 4080 - cj * 16 : cj * 16; }
  };
  for (int i = tid; i < 640; i += 512) {
    int which = i / 320, r = i % 320; int seg = r >> 6, c = r & 63;
    int colb = seg == 0 ? h * 64 : seg == 1 ? 512 + h * 64 : seg == 2 ? 1024 + h * 64 : seg == 3 ? 1536 + d * 64 : 1664 + d * 64;
    mus[i] = mu[which * 1920 + colb + c];
  }
  lbar();
  if (wave < 4) {
    __builtin_amdgcn_s_setprio(3);
    f32x4 S[4];
#pragma unroll
    for (int j = 0; j < 4; ++j) S[j] = (f32x4){0.f, 0.f, 0.f, 0.f};
#pragma unroll 1
    for (int k = 0; k <= 272; ++k) {
      lbar();
      if (k == 0 || (SCANMODE >= 1 && rep == 0)) {
#pragma unroll 1
        for (int t = 0; t < 16; ++t) lbar();
        continue;
      }
      const float* sb = sb0 + ((k - 1) & 1) * 6144; const float* bg = bg0 + ((k - 1) & 1) * 128; float* yp = yp0 + ((k - 1) & 1) * 4096;
      const float* sbw = sb + wave * 16;
      { const f32x4* kp = (const f32x4*)(sbw + 4 * 64);
        part[wave * 64 + lane] = dot16(S, kp[0], kp[1], kp[2], kp[3]); }
      f32x4 wA[4], nA[4]; float viA; float2 gA;
      f32x4 wB[4], nB[4]; float viB; float2 gB;
#define LOADSTEP(t_, X) do { const float* s_ = sbw + (t_) * 384; \
        _Pragma("unroll") for (int j = 0; j < 4; ++j) { w##X[j] = *(const f32x4*)(s_ + 1 * 64 + 4 * j); n##X[j] = *(const f32x4*)(s_ + 384 + 4 * 64 + 4 * j); } \
        vi##X = sb[(t_) * 384 + 3 * 64 + lane]; g##X = *(const float2*)&bg[((t_) * 4 + wave) * 2]; } while (0)
#define STEP(t_, X, Y_) do { \
        lbar1(); \
        const float* pp = part + ((t_) & 1) * 256; \
        float q0 = pp[lane], q1 = pp[64 + lane], q2 = pp[128 + lane], q3 = pp[192 + lane]; \
        f32x4 b_[4], k_[4], r_[4]; \
        { const float* s_ = sbw + (t_) * 384; \
          _Pragma("unroll") for (int j = 0; j < 4; ++j) { b_[j] = *(const f32x4*)(s_ + 5 * 64 + 4 * j); k_[j] = *(const f32x4*)(s_ + 2 * 64 + 4 * j); } \
          _Pragma("unroll") for (int j = 0; j < 4; ++j) r_[j] = *(const f32x4*)(s_ + 0 * 64 + 4 * j); } \
        if ((t_) < 15) LOADSTEP((t_) + 1, Y_); \
        f32x4 Dv[4]; \
        _Pragma("unroll") for (int j = 0; j < 4; ++j) Dv[j] = S[j] * w##X[j]; \
        float A = dot16(Dv, n##X[0], n##X[1], n##X[2], n##X[3]); \
        float sa = (q0 + q1) + (q2 + q3); \
        if ((t_) < 15) part[(((t_) + 1) & 1) * 256 + wave * 64 + lane] = A - sa * g##X.x + vi##X * g##X.y; \
        asm volatile("" ::: "memory");     \
        _Pragma("unroll") for (int j = 0; j < 4; ++j) S[j] = Dv[j] - b_[j] * sa + k_[j] * vi##X; \
        yp[((t_) * 4 + wave) * 64 + lane] = dot16(S, r_[0], r_[1], r_[2], r_[3]); } while (0)
      LOADSTEP(0, A);
#pragma unroll 1
      for (int t = 0; t < 16; t += 2) { STEP(t, A, B); STEP(t + 1, B, A); }
#undef LOADSTEP
#undef STEP
    }
    __builtin_amdgcn_s_setprio(0);
  } else {
    const int pw = wave - 4;
    const int cB = pw * 16 + (lane & 15);
    bf16x8 wfW[2], wfA[2];
    { const float* W = p.in[14] + (size_t)(e * 2 + d) * 64 * 512 + h * 64 + cB;
      const float* Am = p.in[16] + (size_t)(e * 2 + d) * 64 * 512 + h * 64 + cB;
#pragma unroll
      for (int ks = 0; ks < 2; ++ks)
#pragma unroll
        for (int j = 0; j < 8; ++j) { size_t ro = (size_t)(ks * 32 + 8 * (lane >> 4) + j) * 512; wfW[ks][j] = (short)f2bf(W[ro]); wfA[ks][j] = (short)f2bf(Am[ro]); } }
    const float kkc = p.in[18][e * 512 + h * 64 + lane];
    const float kacB = p.in[19][e * 512 + h * 64 + cB];
    const float w0cB = p.in[13][(e * 2 + d) * 512 + h * 64 + cB], a0cB = p.in[15][(e * 2 + d) * 512 + h * 64 + cB];
    float m0[5], m1[5];
#pragma unroll
    for (int seg = 0; seg < 5; ++seg) { m0[seg] = mus[seg * 64 + lane]; m1[seg] = mus[320 + seg * 64 + lane]; }
    u16 pvP[20], pvC[20], pvN[20];
    int t0n = 0, Tn = 1; const u16* rowp0 = P;
#define LOADGEO(ci_) do { size_t rbn_; chunk_geo((ci_), t0n, Tn, rbn_); rowp0 = P + (rbn_ + (size_t)t0n) * EVC + RW; } while (0)
#define LOADITEM(u_, seg_) do { \
      const int i_ = pw + 4 * (u_); const int rel_ = d ? 15 - i_ : i_; const int pos_ = t0n + rel_; \
      const int colb_ = (seg_) == 0 ? h * 64 : (seg_) == 1 ? 512 + h * 64 : (seg_) == 2 ? 1024 + h * 64 : (seg_) == 3 ? 1536 + d * 64 : 1664 + d * 64; \
      const u16* sp_ = rowp0 + (rel_ * EVC + colb_);     \
        \
      pvC[(u_) * 5 + (seg_)] = sp_[lane]; pvP[(u_) * 5 + (seg_)] = (sp_ - (pos_ > 0 ? EVC : 0))[lane]; \
      pvN[(u_) * 5 + (seg_)] = (sp_ + (pos_ < Tn - 1 ? EVC : 0))[lane]; } while (0)
#define STEPA(u_, seg_) do { const int i_ = pw + 4 * (u_); const int posa_ = d ? ta0 + 15 - i_ : ta0 + i_; \
      const float cur_ = bf2f(pvC[(u_) * 5 + (seg_)]), prv_ = posa_ > 0 ? bf2f(pvP[(u_) * 5 + (seg_)]) : 0.f, nxt_ = posa_ < Ta - 1 ? bf2f(pvN[(u_) * 5 + (seg_)]) : 0.f; \
      const float f_ = cur_ + m0[(seg_)] * (prv_ - cur_) + m1[(seg_)] * (nxt_ - cur_); \
      if ((seg_) == 0) sb[(i_ * 6 + 0) * 64 + lane] = f_; \
      else if ((seg_) == 1) { tk[i_ * 64 + lane] = f_; float kn_ = f_ * kkc; float ss_ = wave_sum(kn_ * kn_); sb[(i_ * 6 + 4) * 64 + lane] = kn_ * rsqrtf(ss_ + 1e-6f); } \
      else if ((seg_) == 2) sb[(i_ * 6 + 3) * 64 + lane] = f_; \
      else if ((seg_) == 3) ttwb[i_ * 72 + lane] = f2bf(fast_tanh(f_)); \
      else talb[i_ * 72 + lane] = f2bf(f_); } while (0)
    LOADGEO(0);
#pragma unroll
    for (int u = 0; u < 4; ++u)
#pragma unroll
      for (int seg = 0; seg < 5; ++seg) LOADITEM(u, seg);
#pragma unroll 1
    for (int k = 0; k <= 272; ++k) {
      float* sb = sb0 + (k & 1) * 6144; float* bg = bg0 + (k & 1) * 128; const float* ypf = yp0 + (k & 1) * 4096;
      const bool prep = k < 272 && !(SCANMODE == 2 && rep == 0);
      const bool nxt = k + 1 < 272;
      int ta0 = 0, Ta = 1; { size_t rba_; if (k < 272) chunk_geo(k, ta0, Ta, rba_); }
      lbar();
      if (prep) { STEPA(0, 0); STEPA(0, 1); }
      lbar();
      if (prep) { STEPA(0, 2); STEPA(0, 3); }
      lbar();
      if (prep) { STEPA(0, 4); STEPA(1, 0); }
      lbar();
      if (prep) { STEPA(1, 1); STEPA(1, 2); }
      lbar();
      if (prep) { STEPA(1, 3); STEPA(1, 4); }
      lbar();
      if (prep) { STEPA(2, 0); STEPA(2, 1); }
      lbar();
      if (prep) { STEPA(2, 2); STEPA(2, 3); }
      lbar();
      if (prep) { STEPA(2, 4); STEPA(3, 0); }
      lbar();
      if (prep) { STEPA(3, 1); STEPA(3, 2); }
      lbar();
      if (prep) { STEPA(3, 3); STEPA(3, 4); }
      lbar();
      if (prep) {
        const int ao = (lane & 15) * 72 + 8 * (lane >> 4);
        bf16x8 t0_ = *(const bf16x8*)(ttwb + ao), t1_ = *(const bf16x8*)(ttwb + ao + 32);
        bf16x8 l0_ = *(const bf16x8*)(talb + ao), l1_ = *(const bf16x8*)(talb + ao + 32);
        f32x4 accW = (f32x4){0.f, 0.f, 0.f, 0.f}, accA = (f32x4){0.f, 0.f, 0.f, 0.f};
        accW = __builtin_amdgcn_mfma_f32_16x16x32_bf16(t0_, wfW[0], accW, 0, 0, 0);
        accW = __builtin_amdgcn_mfma_f32_16x16x32_bf16(t1_, wfW[1], accW, 0, 0, 0);
        accA = __builtin_amdgcn_mfma_f32_16x16x32_bf16(l0_, wfA[0], accA, 0, 0, 0);
        accA = __builtin_amdgcn_mfma_f32_16x16x32_bf16(l1_, wfA[1], accA, 0, 0, 0);
#pragma unroll
        for (int rg = 0; rg < 4; ++rg) {
          const int i = 4 * (lane >> 4) + rg;
          float xx = -(w0cB + accW[rg]);
          float sp = fmaxf(xx, 0.f) + __logf(1.f + __expf(-fabsf(xx)));
          float ee = __expf(-sp - 0.5f);
          sb[(i * 6 + 1) * 64 + cB] = __expf(-ee);
          float a = __builtin_amdgcn_rcpf(1.f + __expf(-(a0cB + accA[rg])));
          const float kdv = tk[i * 64 + cB] * (1.f + (a - 1.f) * kacB);
          const float bv = sb[(i * 6 + 4) * 64 + cB] * a;
          sb[(i * 6 + 2) * 64 + cB] = kdv;
          sb[(i * 6 + 5) * 64 + cB] = bv;
          const float kkn = i < 15 ? sb[((i + 1) * 6 + 4) * 64 + cB] : 0.f;
          const float bb = row_sum16(bv * kkn), gg = row_sum16(kdv * kkn);
          if ((lane & 15) == 0 && i < 15) { bg[(i * 4 + pw) * 2] = bb; bg[(i * 4 + pw) * 2 + 1] = gg; }
        }
      }
      lbar();
      if (nxt) { LOADGEO(k + 1); LOADITEM(0, 0); LOADITEM(0, 1); LOADITEM(0, 2); LOADITEM(0, 3); LOADITEM(0, 4);
                 LOADITEM(1, 0); LOADITEM(1, 1); LOADITEM(1, 2); LOADITEM(1, 3); LOADITEM(1, 4); }
      lbar();
      if (nxt) { LOADITEM(2, 0); LOADITEM(2, 1); LOADITEM(2, 2); LOADITEM(2, 3); LOADITEM(2, 4);
                 LOADITEM(3, 0); LOADITEM(3, 1); LOADITEM(3, 2); LOADITEM(3, 3); LOADITEM(3, 4); }
      lbar();
      if (k >= 2) {
        int t0, T; size_t rowbase; chunk_geo(k - 2, t0, T, rowbase);
#pragma unroll
        for (int u = 0; u < 4; ++u) {
          const int s = pw * 4 + u;
          float yv = (ypf[(s * 4 + 0) * 64 + lane] + ypf[(s * 4 + 1) * 64 + lane]) + (ypf[(s * 4 + 2) * 64 + lane] + ypf[(s * 4 + 3) * 64 + lane]);
          int pos = d ? t0 + 15 - s : t0 + s;
          Y[((rowbase + pos) * 2 + d) * 512 + h * 64 + lane] = f2bf(yv);
        }
      }
      lbar();
      lbar();
      lbar();
    }
#undef LOADITEM
#undef LOADGEO
#undef STEPA
  }
  lbar();
  {
    const float* ypf = yp0 + (271 & 1) * 4096;
    int t0, T; size_t rowbase; chunk_geo(271, t0, T, rowbase);
#pragma unroll
    for (int u = 0; u < 2; ++u) {
      const int s = wave + 8 * u;
      float yv = (ypf[(s * 4 + 0) * 64 + lane] + ypf[(s * 4 + 1) * 64 + lane]) + (ypf[(s * 4 + 2) * 64 + lane] + ypf[(s * 4 + 3) * 64 + lane]);
      int pos = d ? t0 + 15 - s : t0 + s;
      Y[((rowbase + pos) * 2 + d) * 512 + h * 64 + lane] = f2bf(yv);
    }
  }
  lbar();
}

__device__ void phase_mix(const Params& p, int l, int rep) {
  const bool even = !(l & 1); const int e = l >> 1;
  if (even && !(rep == 0 && DUPSKIP == 2)) { for (int ch = obid(); ch < 128; ch += gridDim.x) scan_chain(p, e, ch, rep); }
  if (rep == 0 && DUPSKIP == 1) return;
  const int NQ = even ? 8 : 16, NKV = even ? 2 : 4;
  const int nlat = 8 * NKV * 64, nctx = (l == 3) ? 0 : 8 * NKV * 4;
  unsigned* cnt = (unsigned*)(p.ws + WS_CNT) + l + (rep ? 0 : 8);
  volatile int* slot = (volatile int*)(g_lds + 40960);
  const float* sinkp = even ? nullptr : p.in[25] + e * 16;
  for (;;) {
    __syncthreads();
    if (otid() == 0) *slot = (int)atomicAdd(cnt, 1u);
    __syncthreads();
    int item = *slot;
    if (item >= nlat + nctx) break;
    int b, kvh, q0;
    if (item < nlat) { int qt = item & 63; int r = item >> 6; kvh = r % NKV; b = r / NKV; q0 = qt * 64; }
    else { int it2 = item - nlat; int qt = it2 & 3; int r = it2 >> 2; kvh = r % NKV; b = r / NKV; q0 = 4096 + qt * 64; }
    attn_item(p, NQ, NKV, b, kvh, q0, !even, !even, sinkp);
  }
}

__device__ void phase_readout(const Params& p, int e) {
  const int tid = otid(), lane = tid & 63, wave = __builtin_amdgcn_readfirstlane(tid >> 6);
  const u16* P = (const u16*)(p.ws + WS_ACT);
  const u16* Y = (const u16*)(p.ws + WS_Y);
  u16* O = (u16*)(p.ws + WS_H);
  u16* sgb = (u16*)g_lds;
  const float* mu = p.in[12] + (size_t)e * 2 * 1920;
  const float* g2 = p.in[17] + (size_t)e * 128 * 512;
  const int l15 = lane & 15, lq = lane >> 4;
  bf16x8 gf[4][4];
#pragma unroll
  for (int ks = 0; ks < 4; ++ks)
#pragma unroll
    for (int nt = 0; nt < 4; ++nt)
#pragma unroll
      for (int j = 0; j < 8; ++j) gf[ks][nt][j] = (short)f2bf(g2[(size_t)(ks * 32 + 8 * lq + j) * 512 + wave * 64 + nt * 16 + l15]);
  float gnw[4], gnb[4], rkc[4], mr0[4], mr1[4], mk0[4], mk1[4], mv0[4], mv1[4];
#pragma unroll
  for (int nt = 0; nt < 4; ++nt) {
    const int c = wave * 64 + nt * 16 + l15;
    gnw[nt] = p.in[21][e * 512 + c]; gnb[nt] = p.in[22][e * 512 + c]; rkc[nt] = p.in[20][e * 512 + c];
    mr0[nt] = mu[c]; mr1[nt] = mu[1920 + c]; mk0[nt] = mu[512 + c]; mk1[nt] = mu[1920 + 512 + c]; mv0[nt] = mu[1024 + c]; mv1[nt] = mu[1920 + 1024 + c];
  }
  const int gq = tid & 31, gt = tid >> 5;
  float mg0[4], mg1[4];
#pragma unroll
  for (int j = 0; j < 4; ++j) { mg0[j] = mu[1792 + 4 * gq + j]; mg1[j] = mu[1920 + 1792 + 4 * gq + j]; }
  for (int tile = obid(); tile < MTOT / 32; tile += gridDim.x) {
    const int row0 = tile * 32; const bool lat = row0 < MLAT;
    const int T = lat ? 4096 : 256; const int pos0 = lat ? (row0 & 4095) : ((row0 - MLAT) & 255);
#pragma unroll
    for (int u = 0; u < 2; ++u) {
      const int ti = gt + 16 * u; const int row = row0 + ti, pos = pos0 + ti;
      const u16* gp = P + (size_t)row * EVC + RW + 1792 + 4 * gq;
      const uint2 cu = *(const uint2*)gp;
      const uint2 pu = pos > 0 ? *(const uint2*)(gp - EVC) : make_uint2(0u, 0u);
      const uint2 nu = pos < T - 1 ? *(const uint2*)(gp + EVC) : make_uint2(0u, 0u);
      float cf[4] = {__uint_as_float(cu.x << 16), __uint_as_float(cu.x & 0xffff0000u), __uint_as_float(cu.y << 16), __uint_as_float(cu.y & 0xffff0000u)};
      float pf[4] = {__uint_as_float(pu.x << 16), __uint_as_float(pu.x & 0xffff0000u), __uint_as_float(pu.y << 16), __uint_as_float(pu.y & 0xffff0000u)};
      float nf[4] = {__uint_as_float(nu.x << 16), __uint_as_float(nu.x & 0xffff0000u), __uint_as_float(nu.y << 16), __uint_as_float(nu.y & 0xffff0000u)};
      float sgv[4];
#pragma unroll
      for (int j = 0; j < 4; ++j) { float f = cf[j] + mg0[j] * (pf[j] - cf[j]) + mg1[j] * (nf[j] - cf[j]); sgv[j] = __builtin_amdgcn_rcpf(1.f + __expf(-f)); }
      uint2 o; o.x = pack2(sgv[0], sgv[1]); o.y = pack2(sgv[2], sgv[3]);
      *(uint2*)&sgb[ti * 136 + 4 * gq] = o;
    }
    __syncthreads();
    f32x4 acc[2][4];
#pragma unroll
    for (int mt = 0; mt < 2; ++mt)
#pragma unroll
      for (int nt = 0; nt < 4; ++nt) acc[mt][nt] = (f32x4){0.f, 0.f, 0.f, 0.f};
#pragma unroll
    for (int mt = 0; mt < 2; ++mt)
#pragma unroll
      for (int ks = 0; ks < 4; ++ks) {
        const bf16x8 af = *(const bf16x8*)&sgb[(mt * 16 + l15) * 136 + ks * 32 + 8 * lq];
#pragma unroll
        for (int nt = 0; nt < 4; ++nt) acc[mt][nt] = __builtin_amdgcn_mfma_f32_16x16x32_bf16(af, gf[ks][nt], acc[mt][nt], 0, 0, 0);
      }
#pragma unroll
    for (int mt = 0; mt < 2; ++mt)
#pragma unroll
      for (int rg = 0; rg < 4; ++rg) {
        const int ti = mt * 16 + 4 * lq + rg; const int row = row0 + ti, pos = pos0 + ti;
        const bool hp = pos > 0, hn = pos < T - 1;
        const int offp = hp ? -EVC : 0, offn = hn ? EVC : 0;
        const u16* pr = P + (size_t)row * EVC + RW + wave * 64 + l15;
        const u16* yr = Y + (size_t)row * 1024 + wave * 64 + l15;
        u16 yv[4][2], cv[4][3], pv[4][3], nv[4][3];
#pragma unroll
        for (int nt = 0; nt < 4; ++nt) {
          yv[nt][0] = yr[nt * 16]; yv[nt][1] = yr[512 + nt * 16];
#pragma unroll
          for (int w = 0; w < 3; ++w) {
            cv[nt][w] = pr[w * 512 + nt * 16];
            pv[nt][w] = pr[w * 512 + nt * 16 + offp];
            nv[nt][w] = pr[w * 512 + nt * 16 + offn];
          }
        }
        float y[4], rs[4], ks_[4], vs[4];
        float ysum = 0.f, rksum = 0.f;
#pragma unroll
        for (int nt = 0; nt < 4; ++nt) {
          y[nt] = bf2f(yv[nt][0]) + bf2f(yv[nt][1]); ysum += y[nt];
          const float rc = bf2f(cv[nt][0]), kc = bf2f(cv[nt][1]), vc = bf2f(cv[nt][2]);
          const float pm = hp ? 1.f : 0.f, nm = hn ? 1.f : 0.f;
          rs[nt] = rc + mr0[nt] * (pm * bf2f(pv[nt][0]) - rc) + mr1[nt] * (nm * bf2f(nv[nt][0]) - rc);
          ks_[nt] = kc + mk0[nt] * (pm * bf2f(pv[nt][1]) - kc) + mk1[nt] * (nm * bf2f(nv[nt][1]) - kc);
          vs[nt] = vc + mv0[nt] * (pm * bf2f(pv[nt][2]) - vc) + mv1[nt] * (nm * bf2f(nv[nt][2]) - vc);
          rksum += rs[nt] * ks_[nt] * rkc[nt];
        }
        const float mean = row_sum16(ysum) * (1.f / 64.f);
        float vsum = 0.f;
#pragma unroll
        for (int nt = 0; nt < 4; ++nt) { y[nt] -= mean; vsum += y[nt] * y[nt]; }
        const float rstd = rsqrtf(row_sum16(vsum) * (1.f / 64.f) + 64e-5f);
        const float bsum = row_sum16(rksum);
        u16* orow = O + (size_t)row * D + 512 + wave * 64 + l15;
#pragma unroll
        for (int nt = 0; nt < 4; ++nt) orow[nt * 16] = f2bf((y[nt] * rstd * gnw[nt] + gnb[nt] + bsum * vs[nt]) * acc[mt][nt][rg]);
      }
    __syncthreads();
  }
}

__device__ void phase_final(const Params& p) {
  const int tid_ = otid(); const int lane = tid_ & 63, wave = tid_ >> 6;
  const float* fg = p.in[26];
  for (int row = obid() * 8 + wave; row < MLAT; row += gridDim.x * 8) {
    float4* xr = (float4*)(p.out + (size_t)row * D);
    float4 v[4]; float ss = 0.f;
#pragma unroll
    for (int q = 0; q < 4; ++q) { v[q] = xr[lane + q * 64]; ss += v[q].x * v[q].x + v[q].y * v[q].y + v[q].z * v[q].z + v[q].w * v[q].w; }
    ss = wave_sum(ss);
    float rstd = rsqrtf(ss * (1.f / 1024.f) + 1e-6f);
#pragma unroll
    for (int q = 0; q < 4; ++q) {
      float4 g = *(const float4*)(fg + (lane + q * 64) * 4);
      xr[lane + q * 64] = make_float4(v[q].x * rstd * g.x, v[q].y * rstd * g.y, v[q].z * rstd * g.z, v[q].w * rstd * g.w);
    }
  }
}

#define XB_TMO      128
#define XB_XCNT(j)  (256  + 64 * (j))
#define XB_XSUB(j)  (1280 + 64 * (j))
#define XB_XGEN(j)  (2304 + 64 * (j))
#define XB_TOP      3328
#define XB_TOPGEN   3392
#define XCD_BAR_WORDS 3456
#define XB_SPIN_CAP (1u << 18)
#define LAS __attribute__((address_space(3)))

__device__ __forceinline__ unsigned xb_ld(unsigned* p)              { return __hip_atomic_load(p, __ATOMIC_RELAXED, __HIP_MEMORY_SCOPE_AGENT); }
__device__ __forceinline__ unsigned xb_add(unsigned* p, unsigned v) { return __hip_atomic_fetch_add(p, v, __ATOMIC_RELAXED, __HIP_MEMORY_SCOPE_AGENT); }
__device__ __forceinline__ unsigned xb_xcc_id() { return (unsigned)__builtin_amdgcn_s_getreg((3 << 11) | 20) & 0xFu; }
#define XB_SPIN(cond, bar) do { unsigned _sp = 0; while (cond) { __builtin_amdgcn_s_sleep(1); \
    if ((++_sp & 255u) == 0u) { if (xb_ld(&(bar)[XB_TMO])) break; if (_sp > XB_SPIN_CAP) { atomicAdd(&(bar)[XB_TMO], 1u); break; } } } } while (0)

struct XcdBarrier {
    unsigned* bar; unsigned x;
    volatile LAS unsigned* st;
};

__device__ __forceinline__ XcdBarrier xcd_barrier_post(unsigned* bar, volatile LAS unsigned* st) {
    XcdBarrier b; b.bar = bar; b.x = xb_xcc_id(); b.st = st;
    if (threadIdx.x == 0) (void)xb_add(&bar[XB_XCNT(b.x)], 1u);
    return b;
}
__device__ __forceinline__ void xcd_barrier_complete(unsigned* bar, unsigned x, unsigned& nloc, unsigned& nx) {
    const unsigned G = gridDim.x * gridDim.y * gridDim.z;
    unsigned sum, cnt, mine, sp = 0u;
    for (;;) {
        sum = 0u; cnt = 0u; mine = 0u;
#pragma unroll
        for (unsigned j = 0; j < 16; ++j) { const unsigned c = xb_ld(&bar[XB_XCNT(j)]); sum += c; cnt += (c > 0u) ? 1u : 0u; mine = (j == x) ? c : mine; }
        if (sum == G) break;
        __builtin_amdgcn_s_sleep(1);
        if ((++sp & 255u) == 0u) { if (xb_ld(&bar[XB_TMO])) break; if (sp > XB_SPIN_CAP) { atomicAdd(&bar[XB_TMO], 1u); break; } }
    }
    nloc = mine > 0u ? mine : 1u; nx = cnt > 0u ? cnt : 1u;
}

__device__ __forceinline__ void xcd_barrier(const XcdBarrier& b) {
    asm volatile("s_waitcnt vmcnt(0)" ::: "memory");
    __syncthreads();
    if (threadIdx.x == 0) {
        unsigned* bar = b.bar;
        __builtin_amdgcn_s_waitcnt(0);
        unsigned nloc = b.st[0], nx = b.st[1];
        if (nloc == 0u) { xcd_barrier_complete(bar, b.x, nloc, nx); b.st[0] = nloc; b.st[1] = nx; }
        const unsigned old = xb_add(&bar[XB_XSUB(b.x)], 1u);
        const unsigned gen = old / nloc;
        if (old + 1u == (gen + 1u) * nloc) {
            __builtin_amdgcn_fence(__ATOMIC_RELEASE, "agent");
            asm volatile("s_waitcnt vmcnt(0)" ::: "memory");
            const unsigned og = xb_add(&bar[XB_TOP], 1u);
            const unsigned tg = og / nx;
            if (og + 1u == (tg + 1u) * nx) xb_add(&bar[XB_TOPGEN], 1u);
            else XB_SPIN(xb_ld(&bar[XB_TOPGEN]) == tg, bar);
            __builtin_amdgcn_fence(__ATOMIC_ACQUIRE, "agent");
            xb_add(&bar[XB_XGEN(b.x)], 1u);
            asm volatile("s_waitcnt vmcnt(0)" ::: "memory");
        } else {
            XB_SPIN(xb_ld(&bar[XB_XGEN(b.x)]) == gen, bar);
            __builtin_amdgcn_fence(__ATOMIC_ACQUIRE, "agent");
            asm volatile("s_waitcnt vmcnt(0)" ::: "memory");
        }
    }
    __syncthreads();
}


__device__ void run_phase(const Params& p, int ph, int rep) {
  if (ph == 0) { phase_setup(p); return; }
  if (ph == 1) { phase_mod(p); return; }
  if (ph == 50) { phase_final(p); return; }
  const int l = (ph - 2) / 12, s = (ph - 2) % 12;
  const bool even = !(l & 1); const int e = l >> 1;
  const int mrows_late = (l == 3) ? MLAT : MTOT;
  const float* modl = (const float*)(p.ws + WS_MOD) + (size_t)l * 9 * 9216;
  const u16* H = (const u16*)(p.ws + WS_H);
  u16* ACT = (u16*)(p.ws + WS_ACT);
  float* xctx = (float*)(p.ws + WS_XCTX);
  switch (s) {
    case 0: phase_prep(p, l, 0, MTOT); break;
    case 1: { EpiAct ep{ACT}; gemm_phase(H, (const u16*)(p.ws + WS_FFI) + (size_t)(l * 2 + 0) * 5632 * 1024, MTOT, 5632, 1024, ep); } break;
    case 2: { EpiRes ep{p.out, xctx, modl, 2, rep ? 0.5f : 0.f}; gemm_phase(ACT, (const u16*)(p.ws + WS_FFO) + (size_t)(l * 2 + 0) * 1024 * 2816, MTOT, 1024, 2816, ep); } break;
    case 3: phase_prep(p, l, 3, MTOT); break;
    case 4:
      if (even) { EpiP ep{ACT, EVC, EVC, 1.0f}; gemm_phase(H, (const u16*)(p.ws + WS_EVI) + (size_t)e * EVCP * 1024, MTOT, EVCP, 1024, ep); }
      else { EpiP ep{ACT, ODC, ODC, 1.0f}; gemm_phase(H, (const u16*)(p.ws + WS_ODI) + (size_t)e * ODC * 1024, MTOT, ODC, 1024, ep); }
      break;
    case 5: phase_feat(p, l); break;
    case 6: phase_mix(p, l, rep); break;
    case 7: if (even) phase_readout(p, e); break;
    case 8: { EpiRes ep{p.out, xctx, modl, 5, rep ? 1.0f : 0.f};
      gemm_phase(H, (const u16*)(p.ws + (even ? WS_EVO : WS_ODO)) + (size_t)e * 1024 * 1024, mrows_late, 1024, 1024, ep); } break;
    case 9: phase_prep(p, l, 6, mrows_late); break;
    case 10: { EpiAct ep{ACT}; gemm_phase(H, (const u16*)(p.ws + WS_FFI) + (size_t)(l * 2 + 1) * 5632 * 1024, mrows_late, 5632, 1024, ep); } break;
    case 11: { EpiRes ep{p.out, xctx, modl, 8, rep ? 0.5f : 0.f}; gemm_phase(ACT, (const u16*)(p.ws + WS_FFO) + (size_t)(l * 2 + 1) * 1024 * 2816, mrows_late, 1024, 2816, ep); } break;
  }
}

__global__ void __launch_bounds__(512, 2) mega(Params p, int ph_lo, int ph_hi) {
  cg::grid_group grid = cg::this_grid();
  volatile LAS unsigned* st = (volatile LAS unsigned*)(g_lds + 131072);
  XcdBarrier bar; bar.bar = (unsigned*)(p.ws + WS_BAR); bar.x = 0; bar.st = st;
  if (ph_hi - ph_lo > 1) {
    if (threadIdx.x < 2) st[threadIdx.x] = 0u;
    __syncthreads();
    bar = xcd_barrier_post((unsigned*)(p.ws + WS_BAR), st);
  }
  for (int ph = ph_lo; ph < ph_hi; ++ph) {
    int rep0 = 1;
#if DUP
    { bool dup = false;
      if (ph < 2) dup = (DUP & 32) != 0;
      else if (ph < 50) { int s_ = (ph - 2) % 12;
        dup = ((DUP & 1) && (s_ == 1 || s_ == 4 || s_ == 10)) || ((DUP & 2) && s_ == 6) || ((DUP & 4) && (s_ == 0 || s_ == 3 || s_ == 9)) ||
              ((DUP & 8) && (s_ == 5 || s_ == 7)) || ((DUP & 16) && (s_ == 2 || s_ == 8 || s_ == 11)); }
      if (dup) rep0 = 0; }
#endif
#pragma unroll 1
    for (int rep = rep0; rep < 2; ++rep) {
      run_phase(p, ph, rep);
      if (rep == 0 || ph + 1 < ph_hi) {
        if (ph == ph_lo && rep == 1) grid.sync();
        else xcd_barrier(bar);
      }
    }
  }
}

extern "C" void kernel_launch(void* const* d_in, const int* in_sizes, int n_in, void* d_out, int out_size, void* d_ws, size_t ws_size,
                              hipStream_t stream) {
  static int grid = 0;
  if (grid == 0) {
    if (ws_size < WS_END) { fprintf(stderr, "kernel_launch: workspace too small: %zu < %zu\n", ws_size, (size_t)WS_END); grid = -1; return; }
    hipFuncSetAttribute((const void*)mega, hipFuncAttributeMaxDynamicSharedMemorySize, LDS_BYTES);
    int dev = 0, cus = 0, per_cu = 0;
    hipGetDevice(&dev);
    hipDeviceGetAttribute(&cus, hipDeviceAttributeMultiprocessorCount, dev);
    hipOccupancyMaxActiveBlocksPerMultiprocessor(&per_cu, (const void*)mega, 512, LDS_BYTES);
    if (per_cu < 1) per_cu = 1;
    grid = cus * 1;
    (void)hipGetLastError();
  }
  if (grid < 0) return;
  Params p{};
  for (int i = 0; i < 27; ++i) p.in[i] = (const float*)d_in[i];
  p.out = (float*)d_out; p.ws = (unsigned char*)d_ws;
#if MEGA
  hipMemsetAsync((unsigned char*)d_ws + WS_BAR, 0, 16384, stream);
  int lo = 0, hi = NPH;
  void* args[] = {&p, &lo, &hi};
  hipError_t e = hipLaunchCooperativeKernel((const void*)mega, dim3(grid), dim3(512), args, LDS_BYTES, stream);
  if (e != hipSuccess) fprintf(stderr, "cooperative launch failed: %s\n", hipGetErrorString(e));
#else
  for (int ph = 0; ph < NPH; ++ph) {
    if (ph >= 2 && ph < 50) { int l = (ph - 2) / 12, s = (ph - 2) % 12; if (s == 7 && (l & 1)) continue; }
    hipLaunchKernelGGL(mega, dim3(grid), dim3(512), LDS_BYTES, stream, p, ph, ph + 1);
  }
#endif
}
```

```cpp
#include <hip/hip_runtime.h>
#include <hip/hip_cooperative_groups.h>
#include <cstdio>
namespace cg = cooperative_groups;

#ifndef MEGA
#define MEGA 1
#endif
#ifndef DUP
#define DUP 0
#endif
#ifndef DUPSKIP
#define DUPSKIP 0
#endif
#ifndef SCANMODE
#define SCANMODE 0
#endif

typedef unsigned short u16;
using bf16x8 = __attribute__((ext_vector_type(8))) short;
using f32x4  = __attribute__((ext_vector_type(4))) float;
using f32x16 = __attribute__((ext_vector_type(16))) float;
#define DI __device__ __forceinline__

constexpr int D = 1024, MLAT = 32768, MCTX = 2048, MTOT = 34816, NTOK = 4352;
constexpr int DFF = 2816, EVC = 2688, EVCP = 2816, ODC = 1536, RW = 768;
constexpr int NPH = 51;
constexpr int LDS_BYTES = 131072 + 64;

constexpr size_t WS_FFI = 0;
constexpr size_t WS_FFO = WS_FFI + (size_t)8 * 5632 * 1024 * 2;
constexpr size_t WS_EVI = WS_FFO + (size_t)8 * 1024 * 2816 * 2;
constexpr size_t WS_EVO = WS_EVI + (size_t)2 * 2816 * 1024 * 2;
constexpr size_t WS_ODI = WS_EVO + (size_t)2 * 1024 * 1024 * 2;
constexpr size_t WS_ODO = WS_ODI + (size_t)2 * 1536 * 1024 * 2;
constexpr size_t WS_MOD = WS_ODO + (size_t)2 * 1024 * 1024 * 2;
constexpr size_t WS_XCTX = WS_MOD + (size_t)4 * 9 * 9216 * 4;
constexpr size_t WS_H = WS_XCTX + (size_t)MCTX * D * 4;
constexpr size_t WS_ACT = WS_H + (size_t)MTOT * D * 2;
constexpr size_t WS_Q = WS_ACT + (size_t)MTOT * DFF * 2;
constexpr size_t WS_K = WS_Q + (size_t)8 * 16 * NTOK * 64 * 2;
constexpr size_t WS_VT = WS_K + (size_t)8 * 4 * NTOK * 64 * 2;
constexpr size_t WS_Y = WS_VT + (size_t)8 * 4 * NTOK * 64 * 2;
constexpr size_t WS_CNT = WS_Y + (size_t)MTOT * 2 * 512 * 2;
constexpr size_t WS_BAR = WS_CNT + 256;
constexpr size_t WS_END = WS_BAR + 16384;

struct Params {
  const float* in[27];
  float* out;
  unsigned char* ws;
};

extern __shared__ __attribute__((aligned(16))) unsigned char g_lds[];

DI int otid() { int t = threadIdx.x; asm volatile("" : "+v"(t)); return t; }
DI int obid() { int b = blockIdx.x; asm volatile("" : "+s"(b)); return b; }
DI u16 f2bf(float f) { unsigned u = __float_as_uint(f); u += 0x7fffu + ((u >> 16) & 1u); return (u16)(u >> 16); }
DI float bf2f(u16 h) { return __uint_as_float(((unsigned)h) << 16); }
DI unsigned pack2(float a, float b) { unsigned r; asm("v_cvt_pk_bf16_f32 %0, %1, %2" : "=v"(r) : "v"(a), "v"(b)); return r; }
template <int CTRL, int RMASK> DI float dpp_add(float v) {
  return v + __int_as_float(__builtin_amdgcn_update_dpp(0, __float_as_int(v), CTRL, RMASK, 0xF, RMASK == 0xF));
}
DI float row_sum16(float v) {
  v = dpp_add<0xB1, 0xF>(v); v = dpp_add<0x4E, 0xF>(v); v = dpp_add<0x141, 0xF>(v); v = dpp_add<0x140, 0xF>(v);
  return v;
}
DI float wave_sum(float v) {
  v = row_sum16(v);
  v = dpp_add<0x142, 0xA>(v); v = dpp_add<0x143, 0xC>(v);
  return __int_as_float(__builtin_amdgcn_readlane(__float_as_int(v), 63));
}
DI float* xrow(const Params& p, int row) {
  return row < MLAT ? p.out + (size_t)row * D : (float*)(p.ws + WS_XCTX) + (size_t)(row - MLAT) * D;
}

DI void convert_tile(const float* src, int ld_src, u16* dst, int ld_dst, int k0, int nsrc0, int ndst0) {
  float* t = (float*)g_lds;
  const int tid = otid();
#pragma unroll
  for (int it = 0; it < 2; ++it) {
    int idx = tid + it * 512; int i = idx >> 4, j4 = idx & 15;
    float4 v = *(const float4*)(src + (size_t)(k0 + i) * ld_src + nsrc0 + j4 * 4);
    t[(j4 * 4 + 0) * 65 + i] = v.x; t[(j4 * 4 + 1) * 65 + i] = v.y; t[(j4 * 4 + 2) * 65 + i] = v.z; t[(j4 * 4 + 3) * 65 + i] = v.w;
  }
  __syncthreads();
  int n = tid >> 3, kq = tid & 7;
  const float* r = t + n * 65 + kq * 8;
  uint4 o; o.x = pack2(r[0], r[1]); o.y = pack2(r[2], r[3]); o.z = pack2(r[4], r[5]); o.w = pack2(r[6], r[7]);
  *(uint4*)(dst + (size_t)(ndst0 + n) * ld_dst + k0 + kq * 8) = o;
  __syncthreads();
}

__device__ void phase_setup(const Params& p) {
  const int tid = otid();
  const int N_FFI = 8 * 16 * 88, N_FFO = 8 * 44 * 16, N_EVI = 2 * 16 * 42, N_EVO = 2 * 256, N_ODI = 2 * 16 * 24, N_ODO = 2 * 256;
  const int total = N_FFI + N_FFO + N_EVI + N_EVO + N_ODI + N_ODO;
  for (int it = obid(); it < total; it += gridDim.x) {
    int t = it;
    if (t < N_FFI) {
      int m = t / 1408, r = t % 1408; int kt = r & 15, nt = r >> 4;
      int nd = nt * 64; int t256 = nd >> 8, half = (nd >> 7) & 1, c0 = nd & 127;
      convert_tile(p.in[6] + (size_t)m * 1024 * 5632, 5632, (u16*)(p.ws + WS_FFI) + (size_t)m * 5632 * 1024, 1024, kt * 64, half * 2816 + t256 * 128 + c0, nd);
      continue;
    }
    t -= N_FFI;
    if (t < N_FFO) {
      int m = t / 704, r = t % 704; int kt = r % 44, nt = r / 44;
      convert_tile(p.in[7] + (size_t)m * 2816 * 1024, 1024, (u16*)(p.ws + WS_FFO) + (size_t)m * 1024 * 2816, 2816, kt * 64, nt * 64, nt * 64);
      continue;
    }
    t -= N_FFO;
    if (t < N_EVI) {
      int m = t / 672, r = t % 672; int kt = r & 15, nt = r >> 4;
      convert_tile(p.in[8] + (size_t)m * 1024 * EVC, EVC, (u16*)(p.ws + WS_EVI) + (size_t)m * EVCP * 1024, 1024, kt * 64, nt * 64, nt * 64);
      continue;
    }
    t -= N_EVI;
    if (t < N_EVO) {
      int m = t / 256, r = t % 256; int kt = r & 15, nt = r >> 4;
      convert_tile(p.in[9] + (size_t)m * 1024 * 1024, 1024, (u16*)(p.ws + WS_EVO) + (size_t)m * 1024 * 1024, 1024, kt * 64, nt * 64, nt * 64);
      continue;
    }
    t -= N_EVO;
    if (t < N_ODI) {
      int m = t / 384, r = t % 384; int kt = r & 15, nt = r >> 4;
      convert_tile(p.in[23] + (size_t)m * 1024 * ODC, ODC, (u16*)(p.ws + WS_ODI) + (size_t)m * ODC * 1024, 1024, kt * 64, nt * 64, nt * 64);
      continue;
    }
    t -= N_ODI;
    {
      int m = t / 256, r = t % 256; int kt = r & 15, nt = r >> 4;
      convert_tile(p.in[24] + (size_t)m * 1024 * 1024, 1024, (u16*)(p.ws + WS_ODO) + (size_t)m * 1024 * 1024, 1024, kt * 64, nt * 64, nt * 64);
    }
  }
  for (int i = obid() * 512 + tid; i < 2 * 128 * 1024 / 8; i += gridDim.x * 512) {
    int m = i / (128 * 128), r = i % (128 * 128);
    *(uint4*)((u16*)(p.ws + WS_EVI) + (size_t)m * EVCP * 1024 + (size_t)EVC * 1024 + (size_t)r * 8) = make_uint4(0, 0, 0, 0);
  }
  {
    const float4* xs = (const float4*)p.in[0]; float4* xd = (float4*)p.out;
    for (size_t i = (size_t)obid() * 512 + tid; i < (size_t)MLAT * D / 4; i += (size_t)gridDim.x * 512) xd[i] = xs[i];
    const float4* cs = (const float4*)p.in[2]; float4* cd = (float4*)(p.ws + WS_XCTX);
    for (size_t i = (size_t)obid() * 512 + tid; i < (size_t)MCTX * D / 4; i += (size_t)gridDim.x * 512) cd[i] = cs[i];
  }
  if (obid() == 0 && tid < 64) ((unsigned*)(p.ws + WS_CNT))[tid] = 0u;
}

__device__ void phase_mod(const Params& p) {
  const int tid = otid();
  float* sc = (float*)g_lds;
  float* red = sc + 9 * 1024;
  for (int i = tid; i < 9 * 1024; i += 512) {
    int e = i >> 10, k = i & 1023; float v = e < 8 ? p.in[1][e * 1024 + k] : p.in[3][k];
    sc[i] = v / (1.f + __expf(-v));
  }
  __syncthreads();
  float* mod = (float*)(p.ws + WS_MOD);
  for (int tile = obid(); tile < 576; tile += gridDim.x) {
    int l = tile / 144, cgp = tile % 144;
    int cl = tid & 63, kg = tid >> 6;
    const float* w = p.in[4] + (size_t)l * 1024 * 9216 + cgp * 64 + cl;
    float acc[9];
#pragma unroll
    for (int e = 0; e < 9; ++e) acc[e] = 0.f;
    for (int k = kg * 128; k < kg * 128 + 128; ++k) {
      float wv = w[(size_t)k * 9216];
#pragma unroll
      for (int e = 0; e < 9; ++e) acc[e] += sc[e * 1024 + k] * wv;
    }
#pragma unroll
    for (int e = 0; e < 9; ++e) red[(kg * 9 + e) * 64 + cl] = acc[e];
    __syncthreads();
    for (int o = tid; o < 576; o += 512) {
      int e = o >> 6, cc = o & 63; float s = 0.f;
#pragma unroll
      for (int k2 = 0; k2 < 8; ++k2) s += red[(k2 * 9 + e) * 64 + cc];
      mod[(size_t)(l * 9 + e) * 9216 + cgp * 64 + cc] = s + p.in[5][l * 9216 + cgp * 64 + cc];
    }
    __syncthreads();
  }
}

__device__ void phase_prep(const Params& p, int l, int sh, int nrows) {
  const int tid_ = otid(); const int lane = tid_ & 63, wave = tid_ >> 6;
  u16* H = (u16*)(p.ws + WS_H);
  const float* modl = (const float*)(p.ws + WS_MOD) + (size_t)l * 9 * 9216;
  for (int row = obid() * 16 + wave; row < nrows; row += gridDim.x * 16) {
    const float4* xr0 = (const float4*)xrow(p, row);
    const float4* xr1 = (const float4*)xrow(p, row + 8);
    int e = row < MLAT ? row >> 12 : 8;
    const float* m = modl + (size_t)e * 9216;
    float4 v[2][4]; float ss0 = 0.f, ss1 = 0.f;
#pragma unroll
    for (int q = 0; q < 4; ++q) { v[0][q] = xr0[lane + q * 64]; v[1][q] = xr1[lane + q * 64]; }
#pragma unroll
    for (int q = 0; q < 4; ++q) {
      ss0 += v[0][q].x * v[0][q].x + v[0][q].y * v[0][q].y + v[0][q].z * v[0][q].z + v[0][q].w * v[0][q].w;
      ss1 += v[1][q].x * v[1][q].x + v[1][q].y * v[1][q].y + v[1][q].z * v[1][q].z + v[1][q].w * v[1][q].w;
    }
    ss0 = wave_sum(ss0); ss1 = wave_sum(ss1);
    const float rstd0 = rsqrtf(ss0 * (1.f / 1024.f) + 1e-6f), rstd1 = rsqrtf(ss1 * (1.f / 1024.f) + 1e-6f);
#pragma unroll
    for (int q = 0; q < 4; ++q) {
      int col = (lane + q * 64) * 4;
      float4 s4 = *(const float4*)(m + sh * 1024 + col), c4 = *(const float4*)(m + (sh + 1) * 1024 + col);
      uint2 o;
      o.x = pack2(v[0][q].x * rstd0 * (1.f + c4.x) + s4.x, v[0][q].y * rstd0 * (1.f + c4.y) + s4.y);
      o.y = pack2(v[0][q].z * rstd0 * (1.f + c4.z) + s4.z, v[0][q].w * rstd0 * (1.f + c4.w) + s4.w);
      *(uint2*)(H + (size_t)row * D + col) = o;
      o.x = pack2(v[1][q].x * rstd1 * (1.f + c4.x) + s4.x, v[1][q].y * rstd1 * (1.f + c4.y) + s4.y);
      o.y = pack2(v[1][q].z * rstd1 * (1.f + c4.z) + s4.z, v[1][q].w * rstd1 * (1.f + c4.w) + s4.w);
      *(uint2*)(H + (size_t)(row + 8) * D + col) = o;
    }
  }
}

namespace pg8 {
#define PG8_LAS __attribute__((address_space(3)))
typedef unsigned short bf16_t;
typedef unsigned u32x4 __attribute__((ext_vector_type(4)));
constexpr int BM = 256, BK = 64, HALF = 128, HTB = HALF * BK * 2, STAGE_BYTES = 8 * HTB, NXCD = 8, WGM = 8;
__host__ __device__ __forceinline__ int lds_byte(int r, int c) { const int st = (r >> 4) * 2 + (c >> 5), rr = r & 15, cc = c & 31, ob = rr * 64 + cc * 2; return st * 1024 + (ob ^ (((ob >> 9) & 1) << 5)); }
__host__ __device__ __forceinline__ void stage_rc(int b, int& R, int& C) { const int st = b / 1024, sb = b % 1024, swz = sb ^ (((sb >> 9) & 1) << 5); R = (st >> 1) * 16 + swz / 64; C = (st & 1) * 32 + (swz % 64) / 2; }
__host__ __device__ __forceinline__ int perm32(int rho) { const int n = rho >> 4, i = rho & 15; return 8 * (i >> 2) + 4 * n + (i & 3); }
struct Unit { int pm, pn; };
struct Gemm { const bf16_t* A; const bf16_t* Bt; int M, N, K; };
struct StaticOrder {
    int nM, nN, nwg, G, c;
    __host__ __device__ void init(int M, int N, int G_, int c_) { nM = M / BM; nN = N / BM; nwg = nM * nN; G = G_; c = c_; }
    __host__ __device__ bool next(int i, Unit& u) const {
        const long L = (long)i * G + c; if (L >= nwg) return false;
        int wgid = (int)L; { const int q = nwg / NXCD, r = nwg % NXCD, xcd = wgid % NXCD, off = wgid / NXCD; wgid = (xcd < r ? xcd * (q + 1) : r * (q + 1) + (xcd - r) * q) + off; }
        const int nig = WGM * nN, gid = wgid / nig, fm = gid * WGM, gsz = (nM - fm) < WGM ? (nM - fm) : WGM;
        u.pm = fm + ((wgid % nig) % gsz); u.pn = (wgid % nig) / gsz; return true;
    }
    __device__ __forceinline__ void a_ready(const Unit&) const {}
    __device__ __forceinline__ void done(const Unit&) const {}
};
template <class Epi, class Sched, bool STAMP = false>
__device__ __forceinline__ void gemm_phase(PG8_LAS unsigned char* lds, const Gemm g, const Sched& S, const Epi& E, unsigned long long* stamps) {
    const int tid = otid(), wid = __builtin_amdgcn_readfirstlane(tid >> 6), lane = tid & 63, wr = wid >> 2, wc = wid & 3, fr = lane & 15, fq = lane >> 4;
    const int K = g.K, nt = K / BK;
    int ts_lo = 0, ts_hi = 0, nts = 0; const unsigned long long rt_entry = STAMP ? (unsigned long long)wall_clock64() : 0ull;
#define PG8_STAMP() do { if (STAMP && wid == 0 && nts < 64) { const unsigned long long _c = (unsigned long long)clock64(); \
        ts_lo = (lane == nts) ? (int)(unsigned)_c : ts_lo; ts_hi = (lane == nts) ? (int)(unsigned)(_c >> 32) : ts_hi; ++nts; } } while (0)
    PG8_STAMP();
    unsigned voffA[2], voffB[2];
#pragma unroll
    for (int i = 0; i < 2; ++i) { int R, C; stage_rc(tid * 16 + i * 8192, R, C); const int Rb = Epi::PERM ? ((R & ~31) + perm32(R & 31)) : R;
        voffA[i] = (unsigned)(R * K + C) * 2u; voffB[i] = (unsigned)(Rb * K + C) * 2u; }
    const size_t kstep = (size_t)(BK * 2);
    const size_t hstep = (size_t)HALF * K * 2;
    const size_t tstep = 2 * hstep;
    const unsigned ldsw = (unsigned)wid * 1024u;
    const int aoff = lds_byte(wr * 64 + fr, fq * 8), boff = lds_byte(wc * 32 + fr, fq * 8);
#define PG8_SA(b, h) (((b) * 2 + (h)) * HTB)
#define PG8_SB(b, h) ((4 + (b) * 2 + (h)) * HTB)
#define PG8_STAGE(bufoff, gbase, voff) do { _Pragma("unroll") for (int _i = 0; _i < 2; ++_i) \
        __builtin_amdgcn_global_load_lds((const unsigned*)((const char*)(gbase) + (voff)[_i]), (PG8_LAS unsigned*)(lds + (bufoff) + ldsw + _i * 8192), 16, 0, 0); } while (0)
#define PG8_LDA(dst, b, h) do { _Pragma("unroll") for (int m = 0; m < 4; ++m) _Pragma("unroll") for (int k = 0; k < 2; ++k) dst[m][k] = *(const PG8_LAS bf16x8*)(lds + PG8_SA(b, h) + aoff + m * 2048 + k * 1024); } while (0)
#define PG8_LDB(dst, b, h) do { _Pragma("unroll") for (int n = 0; n < 2; ++n) _Pragma("unroll") for (int k = 0; k < 2; ++k) dst[n][k] = *(const PG8_LAS bf16x8*)(lds + PG8_SB(b, h) + boff + n * 2048 + k * 1024); } while (0)
#define PG8_MMA(ai, bj, At, Bt) do { __builtin_amdgcn_s_setprio(1); _Pragma("unroll") for (int m = 0; m < 4; ++m) _Pragma("unroll") for (int n = 0; n < 2; ++n) _Pragma("unroll") for (int k = 0; k < 2; ++k) \
        acc[ai][bj][m][n] = __builtin_amdgcn_mfma_f32_16x16x32_bf16(Bt[n][k], At[m][k], acc[ai][bj][m][n], 0, 0, 0); __builtin_amdgcn_s_setprio(0); } while (0)
#define PG8_WAIT_V(n) asm volatile("s_waitcnt vmcnt(" #n ")" ::: "memory")
#define PG8_WAIT_L(n) asm volatile("s_waitcnt lgkmcnt(" #n ")" ::: "memory")
#define PG8_BAR __builtin_amdgcn_s_barrier()
#define PG8_SCHED __builtin_amdgcn_sched_barrier(0)
    Unit cur, nxt; int ui = 0;
    if (!S.next(0, cur)) return;
    f32x4 acc[2][2][4][2];
#pragma unroll
    for (int a = 0; a < 2; ++a)
#pragma unroll
        for (int b = 0; b < 2; ++b)
#pragma unroll
            for (int m = 0; m < 4; ++m)
#pragma unroll
                for (int n = 0; n < 2; ++n) acc[a][b][m][n] = (f32x4){0.f, 0.f, 0.f, 0.f};
    bf16x8 At[4][2], B0[2][2], B1[2][2];
    const char* cA = (const char*)g.A + (size_t)cur.pm * tstep; const char* cB = (const char*)g.Bt + (size_t)cur.pn * tstep;
    S.a_ready(cur);
    PG8_STAGE(PG8_SB(0, 0), cB, voffB); PG8_STAGE(PG8_SA(0, 0), cA, voffA); PG8_STAGE(PG8_SB(0, 1), cB + hstep, voffB); PG8_STAGE(PG8_SA(0, 1), cA + hstep, voffA);
    if (wr == 1) PG8_BAR;
    PG8_WAIT_V(4); PG8_BAR;
    PG8_STAGE(PG8_SB(1, 0), cB + kstep, voffB); PG8_STAGE(PG8_SA(1, 0), cA + kstep, voffA); PG8_STAGE(PG8_SB(1, 1), cB + hstep + kstep, voffB);
    PG8_WAIT_V(6); PG8_BAR;
    PG8_STAMP();
    for (;;) {
        const bool has_next = S.next(ui + 1, nxt);
        const char* nA = has_next ? (const char*)g.A + (size_t)nxt.pm * tstep : cA; const char* nB = has_next ? (const char*)g.Bt + (size_t)nxt.pn * tstep : cB;
        for (int t = 0; t < nt; t += 2) {
            const bool last = (t == nt - 2);
            const char* a1 = cA + (size_t)(t + 1) * kstep;
            const char* a2 = last ? nA : cA + (size_t)(t + 2) * kstep; const char* b2 = last ? nB : cB + (size_t)(t + 2) * kstep;
            const char* a3 = a2 + kstep; const char* b3 = b2 + kstep;
            if (last && has_next) S.a_ready(nxt);
            PG8_LDB(B0, 0, 0); PG8_SCHED; PG8_LDA(At, 0, 0); PG8_STAGE(PG8_SA(1, 1), a1 + hstep, voffA);
            PG8_WAIT_L(8); PG8_BAR; PG8_WAIT_L(0); PG8_MMA(0, 0, At, B0); PG8_BAR; PG8_SCHED;
            PG8_LDB(B1, 0, 1); PG8_STAGE(PG8_SB(0, 0), b2, voffB);
            PG8_BAR; PG8_WAIT_L(0); PG8_MMA(0, 1, At, B1); PG8_BAR;
            PG8_LDA(At, 0, 1); PG8_STAGE(PG8_SA(0, 0), a2, voffA);
            PG8_BAR; PG8_WAIT_L(0); PG8_MMA(1, 0, At, B0); PG8_BAR; PG8_SCHED;
            PG8_STAGE(PG8_SB(0, 1), b2 + hstep, voffB);
            PG8_WAIT_V(6); PG8_BAR; PG8_MMA(1, 1, At, B1); PG8_BAR;
            PG8_LDB(B0, 1, 0); PG8_SCHED; PG8_LDA(At, 1, 0); PG8_STAGE(PG8_SA(0, 1), a2 + hstep, voffA);
            PG8_WAIT_L(8); PG8_BAR; PG8_WAIT_L(0); PG8_MMA(0, 0, At, B0); PG8_BAR; PG8_SCHED;
            PG8_LDB(B1, 1, 1); PG8_STAGE(PG8_SB(1, 0), b3, voffB);
            PG8_BAR; PG8_WAIT_L(0); PG8_MMA(0, 1, At, B1); PG8_BAR;
            PG8_LDA(At, 1, 1); PG8_STAGE(PG8_SA(1, 0), a3, voffA);
            PG8_BAR; PG8_WAIT_L(0); PG8_MMA(1, 0, At, B0); PG8_BAR; PG8_SCHED;
            PG8_STAGE(PG8_SB(1, 1), b3 + hstep, voffB);
            PG8_WAIT_V(6); PG8_BAR; PG8_MMA(1, 1, At, B1); PG8_BAR;
        }
        PG8_STAMP();
        if constexpr (!Epi::AFTER_DRAIN) { E(acc, cur, wr, wc, fr, fq); S.done(cur); }
        PG8_STAMP();
        if (!has_next) break;
#pragma unroll
        for (int a = 0; a < 2; ++a)
#pragma unroll
            for (int b = 0; b < 2; ++b)
#pragma unroll
                for (int m = 0; m < 4; ++m)
#pragma unroll
                    for (int n = 0; n < 2; ++n) acc[a][b][m][n] = (f32x4){0.f, 0.f, 0.f, 0.f};
        cur = nxt; cA = nA; cB = nB; ++ui;
    }
    PG8_WAIT_V(0);
    if (wr == 0) PG8_BAR;
    PG8_BAR;
    if constexpr (Epi::AFTER_DRAIN) { E.fused(acc, cur, wr, wc, fr, fq, lds, wid, lane); S.done(cur); }
    PG8_STAMP();
    if (STAMP && wid == 0) { stamps[lane] = lane < nts ? (((unsigned long long)(unsigned)ts_hi << 32) | (unsigned)ts_lo) : 0ull;
        if (lane == 62) stamps[62] = rt_entry; if (lane == 63) stamps[63] = (unsigned long long)wall_clock64(); }
#undef PG8_STAMP
#undef PG8_SA
#undef PG8_SB
#undef PG8_STAGE
#undef PG8_LDA
#undef PG8_LDB
#undef PG8_MMA
#undef PG8_WAIT_V
#undef PG8_WAIT_L
#undef PG8_BAR
#undef PG8_SCHED
}
}

struct EpiAct {
  static constexpr bool PERM = true, AFTER_DRAIN = false;
  u16* act;
  DI void operator()(const f32x4 (&acc)[2][2][4][2], const pg8::Unit& u, int wr, int wc, int fr, int fq) const {
    const int row0 = u.pm * 256 + wr * 64 + fr, col0 = u.pn * 128 + wc * 32 + 8 * fq;
#pragma unroll
    for (int ai = 0; ai < 2; ++ai)
#pragma unroll
      for (int m = 0; m < 4; ++m) {
        u16* rowp = act + (size_t)(row0 + ai * 128 + m * 16) * DFF + col0;
        float o[8];
#pragma unroll
        for (int n = 0; n < 2; ++n)
#pragma unroll
          for (int j = 0; j < 4; ++j) { float g = acc[ai][0][m][n][j], up = acc[ai][1][m][n][j]; o[n * 4 + j] = g * up * __builtin_amdgcn_rcpf(1.f + __builtin_amdgcn_exp2f(-1.4426950408889634f * g)); }
        uint4 w; w.x = pack2(o[0], o[1]); w.y = pack2(o[2], o[3]); w.z = pack2(o[4], o[5]); w.w = pack2(o[6], o[7]);
        *(uint4*)rowp = w;
      }
  }
};
struct EpiRes {
  static constexpr bool PERM = false, AFTER_DRAIN = false;
  float* xlat; float* xctx; const float* modl; int gidx; float coef;
  DI void operator()(const f32x4 (&acc)[2][2][4][2], const pg8::Unit& u, int wr, int wc, int fr, int fq) const {
    const int brow = u.pm * 256;
    const int e = brow < MLAT ? brow >> 12 : 8;
    float* xb = (brow < MLAT ? xlat + (size_t)brow * D : xctx + (size_t)(brow - MLAT) * D) + (size_t)(wr * 64 + fr) * D;
    const int col0 = u.pn * 256 + wc * 32 + 4 * fq;
    const float* mg = modl + (size_t)e * 9216 + gidx * 1024 + col0;
    f32x4 gm[2][2];
#pragma unroll
    for (int bj = 0; bj < 2; ++bj)
#pragma unroll
      for (int n = 0; n < 2; ++n) gm[bj][n] = *(const f32x4*)(mg + bj * 128 + n * 16) * coef;
#pragma unroll
    for (int ai = 0; ai < 2; ++ai)
#pragma unroll
      for (int m = 0; m < 4; ++m) {
        float* rowp = xb + (size_t)(ai * 128 + m * 16) * D + col0;
#pragma unroll
        for (int bj = 0; bj < 2; ++bj)
#pragma unroll
          for (int n = 0; n < 2; ++n) {
            f32x4* xp = (f32x4*)(rowp + bj * 128 + n * 16);
            *xp = *xp + gm[bj][n] * acc[ai][bj][m][n];
          }
      }
  }
};
struct EpiP {
  static constexpr bool PERM = true, AFTER_DRAIN = false;
  u16* P; int ld; int nvalid; float one;
  DI void operator()(const f32x4 (&acc)[2][2][4][2], const pg8::Unit& u, int wr, int wc, int fr, int fq) const {
    const int row0 = u.pm * 256 + wr * 64 + fr, col0 = u.pn * 256 + wc * 32 + 8 * fq;
#pragma unroll
    for (int ai = 0; ai < 2; ++ai)
#pragma unroll
      for (int m = 0; m < 4; ++m) {
        u16* rowp = P + (size_t)(row0 + ai * 128 + m * 16) * ld + col0;
#pragma unroll
        for (int bj = 0; bj < 2; ++bj) {
          if (col0 + bj * 128 < nvalid) {
            const f32x4 v0 = acc[ai][bj][m][0] * one, v1 = acc[ai][bj][m][1] * one;
            uint4 w; w.x = pack2(v0[0], v0[1]); w.y = pack2(v0[2], v0[3]); w.z = pack2(v1[0], v1[1]); w.w = pack2(v1[2], v1[3]);
            *(uint4*)(rowp + bj * 128) = w;
          }
        }
      }
  }
};

template <class Epi>
DI void gemm_phase(const u16* A, const u16* Bt, int Mrows, int N, int K, const Epi& epi) {
  pg8::Gemm g{A, Bt, Mrows, N, K};
  pg8::StaticOrder S; S.init(Mrows, N, (int)gridDim.x, obid());
  pg8::gemm_phase<Epi, pg8::StaticOrder, false>((PG8_LAS unsigned char*)g_lds, g, S, epi, nullptr);
}

template <bool EVEN>
__device__ void phase_feat_t(const Params& p, int l) {
  const int tid = otid(), lane = tid & 63, wave = tid >> 6;
  const int e = l >> 1;
  constexpr int NQ = EVEN ? 8 : 16, NKV = EVEN ? 2 : 4, ld = EVEN ? EVC : ODC;
  constexpr int nch = NQ + 2 * NKV, NIT = nch / 2;
  const u16* P = (const u16*)(p.ws + WS_ACT);
  u16* Q = (u16*)(p.ws + WS_Q); u16* Kd = (u16*)(p.ws + WS_K); u16* Vt = (u16*)(p.ws + WS_VT);
  u16* vts = (u16*)g_lds;
  const int i = lane & 31;
  const float qg0 = p.in[10][e * 64 + 2 * i], qg1 = p.in[10][e * 64 + 2 * i + 1];
  const float kg0 = p.in[11][e * 64 + 2 * i], kg1 = p.in[11][e * 64 + 2 * i + 1];
  const float invf = exp2f(-(float)(i & 15) * (13.287712379549449f / 16.f));
  for (int g = obid(); g < MTOT / 64; g += gridDim.x) {
    const int row0 = g * 64; const bool lat = row0 < MLAT;
    int b, tok0;
    if (lat) { b = row0 >> 12; tok0 = row0 & 4095; } else { int r = row0 - MLAT; b = r >> 8; tok0 = 4096 + (r & 255); }
#pragma unroll 2
    for (int tj = 0; tj < 8; ++tj) {
      const int ti = wave + 8 * tj;
      const int row = row0 + ti, tok = tok0 + ti;
      unsigned pv[NIT];
      const u16* prow = P + (size_t)row * ld + (lane >> 5) * 64 + 2 * i;
#pragma unroll
      for (int it = 0; it < NIT; ++it) pv[it] = *(const unsigned*)(prow + it * 128);
      float cs = 1.f, sn = 0.f;
      if (lat) { float pos = (i < 16) ? (float)(tok >> 6) : (float)(tok & 63); float ang = pos * invf; cs = __cosf(ang); sn = __sinf(ang); }
#pragma unroll
      for (int it = 0; it < NIT; ++it) {
        const int ch = it * 2 + (lane >> 5);
        float x0 = bf2f((u16)(pv[it] & 0xffff)), x1 = bf2f((u16)(pv[it] >> 16));
        const bool isq = it * 2 < NQ, isk = !isq && it * 2 < NQ + NKV;
        if (EVEN && (isq || isk)) {
          float ss = row_sum16(x0 * x0 + x1 * x1);
          ss += __shfl_xor(ss, 16);
          float r = rsqrtf(ss * (1.f / 64.f) + 1e-6f);
          x0 *= r * (isq ? qg0 : kg0); x1 *= r * (isq ? qg1 : kg1);
        }
        if (isq || isk) {
          float y0 = x0 * cs - x1 * sn, y1 = x0 * sn + x1 * cs;
          if (isq) {
            const float sc = 0.125f * 1.4426950408889634f;
            *(unsigned*)(Q + ((size_t)(b * NQ + ch) * NTOK + tok) * 64 + 2 * i) = pack2(y0 * sc, y1 * sc);
          } else {
            *(unsigned*)(Kd + ((size_t)(b * NKV + (ch - NQ)) * NTOK + tok) * 64 + 2 * i) = pack2(y0, y1);
          }
        } else {
          int vr = (ch - NQ - NKV) * 64 + 2 * i;
          vts[vr * 72 + ti] = f2bf(x0); vts[(vr + 1) * 72 + ti] = f2bf(x1);
        }
      }
    }
    __syncthreads();
    for (int idx = tid; idx < NKV * 64 * 8; idx += 512) {
      int r = idx >> 3, seg = idx & 7; int kvh = r >> 6, d = r & 63;
      uint4 val = *(const uint4*)&vts[r * 72 + seg * 8];
      *(uint4*)(Vt + ((size_t)(b * NKV + kvh) * 64 + d) * NTOK + tok0 + seg * 8) = val;
    }
    __syncthreads();
  }
}
__device__ void phase_feat(const Params& p, int l) {
  if (l & 1) phase_feat_t<false>(p, l); else phase_feat_t<true>(p, l);
}

DI bf16x8 pack8(const f32x16& x, int s) {
  uint4 r;
  r.x = pack2(x[8 * s + 0], x[8 * s + 1]); r.y = pack2(x[8 * s + 2], x[8 * s + 3]);
  r.z = pack2(x[8 * s + 4], x[8 * s + 5]); r.w = pack2(x[8 * s + 6], x[8 * s + 7]);
  return __builtin_bit_cast(bf16x8, r);
}

__device__ void attn_item(const Params& p, int NQ, int NKV, int b, int kvh, int q0, bool windowed, bool has_sink, const float* sinkp) {
  const int tid = otid(), lane = tid & 63, wave = tid >> 6, r = lane & 31, h = lane >> 5;
  const u16* Q = (const u16*)(p.ws + WS_Q); const u16* Kd = (const u16*)(p.ws + WS_K); const u16* Vt = (const u16*)(p.ws + WS_VT);
  u16* O = (u16*)(p.ws + WS_H);
  const int head = kvh * 4 + (wave >> 1);
  const int qtok = q0 + (wave & 1) * 32 + r;
  const bool is_ctx = q0 >= 4096;
  const u16* qp = Q + ((size_t)(b * NQ + head) * NTOK + qtok) * 64;
  bf16x8 qf[4];
#pragma unroll
  for (int kk = 0; kk < 4; ++kk) qf[kk] = *(const bf16x8*)(qp + kk * 16 + h * 8);
  const u16* Kb = Kd + (size_t)(b * NKV + kvh) * NTOK * 64;
  const u16* Vb = Vt + (size_t)(b * NKV + kvh) * 64 * NTOK;
  int nt, nwin = 0, wlo = 0;
  if (is_ctx) { nt = 4; wlo = 4096; nwin = 0; }
  else if (windowed) { wlo = q0 - 128 < 128 ? 128 : q0 - 128; int whi = q0 + 192 > 4096 ? 4096 : q0 + 192; nwin = (whi - wlo) >> 6; nt = nwin + 4; }
  else { nt = 68; }
#define KSTART(it) (is_ctx ? 4096 + (it) * 64 : (windowed ? ((it) < nwin ? wlo + (it) * 64 : 4096 + ((it) - nwin) * 64) : (it) * 64))
  u16* Ks = (u16*)g_lds; u16* Vs = Ks + 2 * 64 * 72;
  const int lrow = tid >> 3, lseg = tid & 7;
  uint4 kreg, vreg;
  { int ks = KSTART(0);
    kreg = *(const uint4*)(Kb + (size_t)(ks + lrow) * 64 + lseg * 8);
    vreg = *(const uint4*)(Vb + (size_t)lrow * NTOK + ks + lseg * 8);
    *(uint4*)&Ks[lrow * 72 + lseg * 8] = kreg; *(uint4*)&Vs[lrow * 72 + lseg * 8] = vreg; }
  __syncthreads();
  f32x16 ot[2];
#pragma unroll
  for (int i = 0; i < 16; ++i) { ot[0][i] = 0.f; ot[1][i] = 0.f; }
  float mrun = -1e30f, lsum = 0.f;
  if (windowed && !is_ctx) { int nph = qtok + 129 - 4096; if (nph > 0) { mrun = 0.f; lsum = (float)nph; } }
  for (int it = 0; it < nt; ++it) {
    const int cur = it & 1;
    const u16* Kc = Ks + cur * 64 * 72; const u16* Vc = Vs + cur * 64 * 72;
    if (it + 1 < nt) { int ks = KSTART(it + 1);
      kreg = *(const uint4*)(Kb + (size_t)(ks + lrow) * 64 + lseg * 8);
      vreg = *(const uint4*)(Vb + (size_t)lrow * NTOK + ks + lseg * 8); }
    f32x16 st[2];
#pragma unroll
    for (int kt = 0; kt < 2; ++kt) {
#pragma unroll
      for (int i = 0; i < 16; ++i) st[kt][i] = 0.f;
#pragma unroll
      for (int kk = 0; kk < 4; ++kk) {
        bf16x8 kf = *(const bf16x8*)&Kc[(kt * 32 + r) * 72 + kk * 16 + h * 8];
        st[kt] = __builtin_amdgcn_mfma_f32_32x32x16_bf16(kf, qf[kk], st[kt], 0, 0, 0);
      }
    }
    if (windowed && it < nwin) {
      const int ks = KSTART(it);
#pragma unroll
      for (int kt = 0; kt < 2; ++kt)
#pragma unroll
        for (int i = 0; i < 16; ++i) {
          int key = ks + kt * 32 + (i & 3) + 8 * (i >> 2) + 4 * h;
          int dlt = key - qtok; dlt = dlt < 0 ? -dlt : dlt;
          if (dlt > 128) st[kt][i] = -1e30f;
        }
    }
    float mx = -1e30f;
#pragma unroll
    for (int kt = 0; kt < 2; ++kt)
#pragma unroll
      for (int i = 0; i < 16; ++i) mx = fmaxf(mx, st[kt][i]);
    mx = fmaxf(mx, __shfl_xor(mx, 32));
    const float mnew = fmaxf(mrun, mx);
    const float alpha = __builtin_amdgcn_exp2f(mrun - mnew);
    float rs = 0.f;
#pragma unroll
    for (int kt = 0; kt < 2; ++kt)
#pragma unroll
      for (int i = 0; i < 16; ++i) {
        float sv = st[kt][i];
        float pe = sv <= -1e29f ? 0.f : __builtin_amdgcn_exp2f(sv - mnew);
        st[kt][i] = pe; rs += pe;
      }
    rs += __shfl_xor(rs, 32);
    lsum = lsum * alpha + rs;
    mrun = mnew;
#pragma unroll
    for (int i = 0; i < 16; ++i) { ot[0][i] *= alpha; ot[1][i] *= alpha; }
#pragma unroll
    for (int kt = 0; kt < 2; ++kt)
#pragma unroll
      for (int s = 0; s < 2; ++s) {
        bf16x8 pf = pack8(st[kt], s);
#pragma unroll
        for (int db = 0; db < 2; ++db) {
          const u16* vp = &Vc[(db * 32 + r) * 72 + kt * 32 + 16 * s + 4 * h];
          uint2 v0 = *(const uint2*)vp, v1 = *(const uint2*)(vp + 8);
          uint4 vv = make_uint4(v0.x, v0.y, v1.x, v1.y);
          bf16x8 vf = __builtin_bit_cast(bf16x8, vv);
          ot[db] = __builtin_amdgcn_mfma_f32_32x32x16_bf16(vf, pf, ot[db], 0, 0, 0);
        }
      }
    if (it + 1 < nt) {
      u16* Kn = Ks + (cur ^ 1) * 64 * 72; u16* Vn = Vs + (cur ^ 1) * 64 * 72;
      *(uint4*)&Kn[lrow * 72 + lseg * 8] = kreg; *(uint4*)&Vn[lrow * 72 + lseg * 8] = vreg;
    }
    __syncthreads();
  }
#undef KSTART
  if (has_sink) lsum += __builtin_amdgcn_exp2f(sinkp[head] * 1.4426950408889634f - mrun);
  const float inv = 1.f / lsum;
  const size_t orow = is_ctx ? (size_t)MLAT + b * 256 + (qtok - 4096) : (size_t)b * 4096 + qtok;
  u16* op = O + orow * D + head * 64;
#pragma unroll
  for (int db = 0; db < 2; ++db)
#pragma unroll
    for (int g = 0; g < 4; ++g) {
      uint2 o;
      o.x = pack2(ot[db][4 * g + 0] * inv, ot[db][4 * g + 1] * inv);
      o.y = pack2(ot[db][4 * g + 2] * inv, ot[db][4 * g + 3] * inv);
      *(uint2*)(op + db * 32 + 8 * g + 4 * h) = o;
    }
}

DI void lbar() { asm volatile("s_waitcnt lgkmcnt(0)\n\ts_barrier" ::: "memory"); }
DI void bbar() { asm volatile("s_barrier" ::: "memory"); }
DI void lbar1() { asm volatile("s_waitcnt lgkmcnt(1)\n\ts_barrier" ::: "memory"); }
DI float fast_tanh(float x) { float e = __expf(2.f * x); return 1.f - 2.f / (e + 1.f); }
DI float dot16(const f32x4 (&s)[4], const f32x4& a0, const f32x4& a1, const f32x4& a2, const f32x4& a3) {
  f32x4 t = s[0] * a0; t += s[1] * a1; t += s[2] * a2; t += s[3] * a3;
  return (t[0] + t[1]) + (t[2] + t[3]);
}
__device__ void scan_chain(const Params& p, int e, int chain, int rep) {
  const int tid = otid(), lane = tid & 63, wave = __builtin_amdgcn_readfirstlane(tid >> 6);
  const int b = chain >> 4, h = (chain >> 1) & 7, d = chain & 1;
  const u16* P = (const u16*)(p.ws + WS_ACT);
  u16* Y = (u16*)(p.ws + WS_Y);
  float* sb0 = (float*)g_lds;
  float* bg0 = sb0 + 2 * 6144;
  float* part = bg0 + 2 * 128;
  float* yp0 = part + 512;
  float* tk = yp0 + 2 * 4096;
  u16* ttwb = (u16*)(tk + 1024);
  u16* talb = ttwb + 16 * 72;
  float* mus = tk + 1024 + 1152;
  const float* mu = p.in[12] + (size_t)e * 2 * 1920;
  auto chunk_geo = [&](int ci, int& t0, int& T, size_t& rowbase) {
    if (ci < 16) { T = 256; rowbase = (size_t)MLAT + b * 256; t0 = d ? 240 - ci * 16 : ci * 16; }
    else { T = 4096; rowbase = (size_t)b * 4096; int cj = ci - 16; t0 = d ? 4080 - cj * 16 : cj * 16; }
  };
  for (int i = tid; i < 640; i += 512) {
    int which = i / 320, r = i % 320; int seg = r >> 6, c = r & 63;
    int colb = seg == 0 ? h * 64 : seg == 1 ? 512 + h * 64 : seg == 2 ? 1024 + h * 64 : seg == 3 ? 1536 + d * 64 : 1664 + d * 64;
    mus[i] = mu[which * 1920 + colb + c];
  }
  lbar();
  if (wave < 4) {
    __builtin_amdgcn_s_setprio(3);
    f32x4 S[4];
#pragma unroll
    for (int j = 0; j < 4; ++j) S[j] = (f32x4){0.f, 0.f, 0.f, 0.f};
#pragma unroll 1
    for (int k = 0; k <= 272; ++k) {
      lbar();
      if (k == 0 || (SCANMODE >= 1 && rep == 0)) {
#pragma unroll 1
        for (int t = 0; t < 16; ++t) lbar();
        continue;
      }
      const float* sb = sb0 + ((k - 1) & 1) * 6144; const float* bg = bg0 + ((k - 1) & 1) * 128; float* yp = yp0 + ((k - 1) & 1) * 4096;
      const float* sbw = sb + wave * 16;
      { const f32x4* kp = (const f32x4*)(sbw + 4 * 64);
        part[wave * 64 + lane] = dot16(S, kp[0], kp[1], kp[2], kp[3]); }
      f32x4 wA[4], nA[4]; float viA; float2 gA;
      f32x4 wB[4], nB[4]; float viB; float2 gB;
#define LOADSTEP(t_, X) do { const float* s_ = sbw + (t_) * 384; \
        _Pragma("unroll") for (int j = 0; j < 4; ++j) { w##X[j] = *(const f32x4*)(s_ + 1 * 64 + 4 * j); n##X[j] = *(const f32x4*)(s_ + 384 + 4 * 64 + 4 * j); } \
        vi##X = sb[(t_) * 384 + 3 * 64 + lane]; g##X = *(const float2*)&bg[((t_) * 4 + wave) * 2]; } while (0)
#define STEP(t_, X, Y_) do { \
        lbar1(); \
        const float* pp = part + ((t_) & 1) * 256; \
        float q0 = pp[lane], q1 = pp[64 + lane], q2 = pp[128 + lane], q3 = pp[192 + lane]; \
        f32x4 b_[4], k_[4], r_[4]; \
        { const float* s_ = sbw + (t_) * 384; \
          _Pragma("unroll") for (int j = 0; j < 4; ++j) { b_[j] = *(const f32x4*)(s_ + 5 * 64 + 4 * j); k_[j] = *(const f32x4*)(s_ + 2 * 64 + 4 * j); } \
          _Pragma("unroll") for (int j = 0; j < 4; ++j) r_[j] = *(const f32x4*)(s_ + 0 * 64 + 4 * j); } \
        if ((t_) < 15) LOADSTEP((t_) + 1, Y_); \
        f32x4 Dv[4]; \
        _Pragma("unroll") for (int j = 0; j < 4; ++j) Dv[j] = S[j] * w##X[j]; \
        float A = dot16(Dv, n##X[0], n##X[1], n##X[2], n##X[3]); \
        float sa = (q0 + q1) + (q2 + q3); \
        if ((t_) < 15) part[(((t_) + 1) & 1) * 256 + wave * 64 + lane] = A - sa * g##X.x + vi##X * g##X.y; \
        asm volatile("" ::: "memory");     \
        _Pragma("unroll") for (int j = 0; j < 4; ++j) S[j] = Dv[j] - b_[j] * sa + k_[j] * vi##X; \
        yp[((t_) * 4 + wave) * 64 + lane] = dot16(S, r_[0], r_[1], r_[2], r_[3]); } while (0)
      LOADSTEP(0, A);
#pragma unroll 1
      for (int t = 0; t < 16; t += 2) { STEP(t, A, B); STEP(t + 1, B, A); }
#undef LOADSTEP
#undef STEP
    }
    __builtin_amdgcn_s_setprio(0);
  } else {
    const int pw = wave - 4;
    const int cB = pw * 16 + (lane & 15);
    bf16x8 wfW[2], wfA[2];
    { const float* W = p.in[14] + (size_t)(e * 2 + d) * 64 * 512 + h * 64 + cB;
      const float* Am = p.in[16] + (size_t)(e * 2 + d) * 64 * 512 + h * 64 + cB;
#pragma unroll
      for (int ks = 0; ks < 2; ++ks)
#pragma unroll
        for (int j = 0; j < 8; ++j) { size_t ro = (size_t)(ks * 32 + 8 * (lane >> 4) + j) * 512; wfW[ks][j] = (short)f2bf(W[ro]); wfA[ks][j] = (short)f2bf(Am[ro]); } }
    const float kkc = p.in[18][e * 512 + h * 64 + lane];
    const float kacB = p.in[19][e * 512 + h * 64 + cB];
    const float w0cB = p.in[13][(e * 2 + d) * 512 + h * 64 + cB], a0cB = p.in[15][(e * 2 + d) * 512 + h * 64 + cB];
    float m0[5], m1[5];
#pragma unroll
    for (int seg = 0; seg < 5; ++seg) { m0[seg] = mus[seg * 64 + lane]; m1[seg] = mus[320 + seg * 64 + lane]; }
    u16 pvP[20], pvC[20], pvN[20];
    int t0n = 0, Tn = 1; const u16* rowp0 = P;
#define LOADGEO(ci_) do { size_t rbn_; chunk_geo((ci_), t0n, Tn, rbn_); rowp0 = P + (rbn_ + (size_t)t0n) * EVC + RW; } while (0)
#define LOADITEM(u_, seg_) do { \
      const int i_ = pw + 4 * (u_); const int rel_ = d ? 15 - i_ : i_; const int pos_ = t0n + rel_; \
      const int colb_ = (seg_) == 0 ? h * 64 : (seg_) == 1 ? 512 + h * 64 : (seg_) == 2 ? 1024 + h * 64 : (seg_) == 3 ? 1536 + d * 64 : 1664 + d * 64; \
      const u16* sp_ = rowp0 + (rel_ * EVC + colb_);     \
        \
      pvC[(u_) * 5 + (seg_)] = sp_[lane]; pvP[(u_) * 5 + (seg_)] = (sp_ - (pos_ > 0 ? EVC : 0))[lane]; \
      pvN[(u_) * 5 + (seg_)] = (sp_ + (pos_ < Tn - 1 ? EVC : 0))[lane]; } while (0)
#define STEPA(u_, seg_) do { const int i_ = pw + 4 * (u_); const int posa_ = d ? ta0 + 15 - i_ : ta0 + i_; \
      const float cur_ = bf2f(pvC[(u_) * 5 + (seg_)]), prv_ = posa_ > 0 ? bf2f(pvP[(u_) * 5 + (seg_)]) : 0.f, nxt_ = posa_ < Ta - 1 ? bf2f(pvN[(u_) * 5 + (seg_)]) : 0.f; \
      const float f_ = cur_ + m0[(seg_)] * (prv_ - cur_) + m1[(seg_)] * (nxt_ - cur_); \
      if ((seg_) == 0) sb[(i_ * 6 + 0) * 64 + lane] = f_; \
      else if ((seg_) == 1) { tk[i_ * 64 + lane] = f_; float kn_ = f_ * kkc; float ss_ = wave_sum(kn_ * kn_); sb[(i_ * 6 + 4) * 64 + lane] = kn_ * rsqrtf(ss_ + 1e-6f); } \
      else if ((seg_) == 2) sb[(i_ * 6 + 3) * 64 + lane] = f_; \
      else if ((seg_) == 3) ttwb[i_ * 72 + lane] = f2bf(fast_tanh(f_)); \
      else talb[i_ * 72 + lane] = f2bf(f_); } while (0)
    LOADGEO(0);
#pragma unroll
    for (int u = 0; u < 4; ++u)
#pragma unroll
      for (int seg = 0; seg < 5; ++seg) LOADITEM(u, seg);
#pragma unroll 1
    for (int k = 0; k <= 272; ++k) {
      float* sb = sb0 + (k & 1) * 6144; float* bg = bg0 + (k & 1) * 128; const float* ypf = yp0 + (k & 1) * 4096;
      const bool prep = k < 272 && !(SCANMODE == 2 && rep == 0);
      const bool nxt = k + 1 < 272;
      int ta0 = 0, Ta = 1; { size_t rba_; if (k < 272) chunk_geo(k, ta0, Ta, rba_); }
      lbar();
      if (prep) { STEPA(0, 0); STEPA(0, 1); }
      bbar();
      if (prep) { STEPA(0, 2); STEPA(0, 3); }
      bbar();
      if (prep) { STEPA(0, 4); STEPA(1, 0); }
      bbar();
      if (prep) { STEPA(1, 1); STEPA(1, 2); }
      bbar();
      if (prep) { STEPA(1, 3); STEPA(1, 4); }
      bbar();
      if (prep) { STEPA(2, 0); STEPA(2, 1); }
      bbar();
      if (prep) { STEPA(2, 2); STEPA(2, 3); }
      bbar();
      if (prep) { STEPA(2, 4); STEPA(3, 0); }
      bbar();
      if (prep) { STEPA(3, 1); STEPA(3, 2); }
      bbar();
      if (prep) { STEPA(3, 3); STEPA(3, 4); }
      lbar();
      if (prep) {
        const int ao = (lane & 15) * 72 + 8 * (lane >> 4);
        bf16x8 t0_ = *(const bf16x8*)(ttwb + ao), t1_ = *(const bf16x8*)(ttwb + ao + 32);
        bf16x8 l0_ = *(const bf16x8*)(talb + ao), l1_ = *(const bf16x8*)(talb + ao + 32);
        f32x4 accW = (f32x4){0.f, 0.f, 0.f, 0.f}, accA = (f32x4){0.f, 0.f, 0.f, 0.f};
        accW = __builtin_amdgcn_mfma_f32_16x16x32_bf16(t0_, wfW[0], accW, 0, 0, 0);
        accW = __builtin_amdgcn_mfma_f32_16x16x32_bf16(t1_, wfW[1], accW, 0, 0, 0);
        accA = __builtin_amdgcn_mfma_f32_16x16x32_bf16(l0_, wfA[0], accA, 0, 0, 0);
        accA = __builtin_amdgcn_mfma_f32_16x16x32_bf16(l1_, wfA[1], accA, 0, 0, 0);
#pragma unroll
        for (int rg = 0; rg < 4; ++rg) {
          const int i = 4 * (lane >> 4) + rg;
          float xx = -(w0cB + accW[rg]);
          float sp = fmaxf(xx, 0.f) + __logf(1.f + __expf(-fabsf(xx)));
          float ee = __expf(-sp - 0.5f);
          sb[(i * 6 + 1) * 64 + cB] = __expf(-ee);
          float a = __builtin_amdgcn_rcpf(1.f + __expf(-(a0cB + accA[rg])));
          const float kdv = tk[i * 64 + cB] * (1.f + (a - 1.f) * kacB);
          const float bv = sb[(i * 6 + 4) * 64 + cB] * a;
          sb[(i * 6 + 2) * 64 + cB] = kdv;
          sb[(i * 6 + 5) * 64 + cB] = bv;
          const float kkn = i < 15 ? sb[((i + 1) * 6 + 4) * 64 + cB] : 0.f;
          const float bb = row_sum16(bv * kkn), gg = row_sum16(kdv * kkn);
          if ((lane & 15) == 0 && i < 15) { bg[(i * 4 + pw) * 2] = bb; bg[(i * 4 + pw) * 2 + 1] = gg; }
        }
      }
      bbar();
      if (nxt) { LOADGEO(k + 1); LOADITEM(0, 0); LOADITEM(0, 1); LOADITEM(0, 2); LOADITEM(0, 3); LOADITEM(0, 4);
                 LOADITEM(1, 0); LOADITEM(1, 1); LOADITEM(1, 2); LOADITEM(1, 3); LOADITEM(1, 4); }
      bbar();
      if (nxt) { LOADITEM(2, 0); LOADITEM(2, 1); LOADITEM(2, 2); LOADITEM(2, 3); LOADITEM(2, 4);
                 LOADITEM(3, 0); LOADITEM(3, 1); LOADITEM(3, 2); LOADITEM(3, 3); LOADITEM(3, 4); }
      bbar();
      if (k >= 2) {
        int t0, T; size_t rowbase; chunk_geo(k - 2, t0, T, rowbase);
#pragma unroll
        for (int u = 0; u < 4; ++u) {
          const int s = pw * 4 + u;
          float yv = (ypf[(s * 4 + 0) * 64 + lane] + ypf[(s * 4 + 1) * 64 + lane]) + (ypf[(s * 4 + 2) * 64 + lane] + ypf[(s * 4 + 3) * 64 + lane]);
          int pos = d ? t0 + 15 - s : t0 + s;
          Y[((rowbase + pos) * 2 + d) * 512 + h * 64 + lane] = f2bf(yv);
        }
      }
      bbar();
      bbar();
      bbar();
    }
#undef LOADITEM
#undef LOADGEO
#undef STEPA
  }
  lbar();
  {
    const float* ypf = yp0 + (271 & 1) * 4096;
    int t0, T; size_t rowbase; chunk_geo(271, t0, T, rowbase);
#pragma unroll
    for (int u = 0; u < 2; ++u) {
      const int s = wave + 8 * u;
      float yv = (ypf[(s * 4 + 0) * 64 + lane] + ypf[(s * 4 + 1) * 64 + lane]) + (ypf[(s * 4 + 2) * 64 + lane] + ypf[(s * 4 + 3) * 64 + lane]);
      int pos = d ? t0 + 15 - s : t0 + s;
      Y[((rowbase + pos) * 2 + d) * 512 + h * 64 + lane] = f2bf(yv);
    }
  }
  lbar();
}

__device__ void phase_mix(const Params& p, int l, int rep) {
  const bool even = !(l & 1); const int e = l >> 1;
  if (even && !(rep == 0 && DUPSKIP == 2)) { for (int ch = obid(); ch < 128; ch += gridDim.x) scan_chain(p, e, ch, rep); }
  if (rep == 0 && DUPSKIP == 1) return;
  const int NQ = even ? 8 : 16, NKV = even ? 2 : 4;
  const int nlat = 8 * NKV * 64, nctx = (l == 3) ? 0 : 8 * NKV * 4;
  unsigned* cnt = (unsigned*)(p.ws + WS_CNT) + l + (rep ? 0 : 8);
  volatile int* slot = (volatile int*)(g_lds + 40960);
  const float* sinkp = even ? nullptr : p.in[25] + e * 16;
  for (;;) {
    __syncthreads();
    if (otid() == 0) *slot = (int)atomicAdd(cnt, 1u);
    __syncthreads();
    int item = *slot;
    if (item >= nlat + nctx) break;
    int b, kvh, q0;
    if (item < nlat) { int qt = item & 63; int r = item >> 6; kvh = r % NKV; b = r / NKV; q0 = qt * 64; }
    else { int it2 = item - nlat; int qt = it2 & 3; int r = it2 >> 2; kvh = r % NKV; b = r / NKV; q0 = 4096 + qt * 64; }
    attn_item(p, NQ, NKV, b, kvh, q0, !even, !even, sinkp);
  }
}

__device__ void phase_readout(const Params& p, int e) {
  const int tid = otid(), lane = tid & 63, wave = __builtin_amdgcn_readfirstlane(tid >> 6);
  const u16* P = (const u16*)(p.ws + WS_ACT);
  const u16* Y = (const u16*)(p.ws + WS_Y);
  u16* O = (u16*)(p.ws + WS_H);
  u16* sgb = (u16*)g_lds;
  const float* mu = p.in[12] + (size_t)e * 2 * 1920;
  const float* g2 = p.in[17] + (size_t)e * 128 * 512;
  const int l15 = lane & 15, lq = lane >> 4;
  bf16x8 gf[4][4];
#pragma unroll
  for (int ks = 0; ks < 4; ++ks)
#pragma unroll
    for (int nt = 0; nt < 4; ++nt)
#pragma unroll
      for (int j = 0; j < 8; ++j) gf[ks][nt][j] = (short)f2bf(g2[(size_t)(ks * 32 + 8 * lq + j) * 512 + wave * 64 + nt * 16 + l15]);
  float gnw[4], gnb[4], rkc[4], mr0[4], mr1[4], mk0[4], mk1[4], mv0[4], mv1[4];
#pragma unroll
  for (int nt = 0; nt < 4; ++nt) {
    const int c = wave * 64 + nt * 16 + l15;
    gnw[nt] = p.in[21][e * 512 + c]; gnb[nt] = p.in[22][e * 512 + c]; rkc[nt] = p.in[20][e * 512 + c];
    mr0[nt] = mu[c]; mr1[nt] = mu[1920 + c]; mk0[nt] = mu[512 + c]; mk1[nt] = mu[1920 + 512 + c]; mv0[nt] = mu[1024 + c]; mv1[nt] = mu[1920 + 1024 + c];
  }
  const int gq = tid & 31, gt = tid >> 5;
  float mg0[4], mg1[4];
#pragma unroll
  for (int j = 0; j < 4; ++j) { mg0[j] = mu[1792 + 4 * gq + j]; mg1[j] = mu[1920 + 1792 + 4 * gq + j]; }
  for (int tile = obid(); tile < MTOT / 32; tile += gridDim.x) {
    const int row0 = tile * 32; const bool lat = row0 < MLAT;
    const int T = lat ? 4096 : 256; const int pos0 = lat ? (row0 & 4095) : ((row0 - MLAT) & 255);
#pragma unroll
    for (int u = 0; u < 2; ++u) {
      const int ti = gt + 16 * u; const int row = row0 + ti, pos = pos0 + ti;
      const u16* gp = P + (size_t)row * EVC + RW + 1792 + 4 * gq;
      const uint2 cu = *(const uint2*)gp;
      const uint2 pu = pos > 0 ? *(const uint2*)(gp - EVC) : make_uint2(0u, 0u);
      const uint2 nu = pos < T - 1 ? *(const uint2*)(gp + EVC) : make_uint2(0u, 0u);
      float cf[4] = {__uint_as_float(cu.x << 16), __uint_as_float(cu.x & 0xffff0000u), __uint_as_float(cu.y << 16), __uint_as_float(cu.y & 0xffff0000u)};
      float pf[4] = {__uint_as_float(pu.x << 16), __uint_as_float(pu.x & 0xffff0000u), __uint_as_float(pu.y << 16), __uint_as_float(pu.y & 0xffff0000u)};
      float nf[4] = {__uint_as_float(nu.x << 16), __uint_as_float(nu.x & 0xffff0000u), __uint_as_float(nu.y << 16), __uint_as_float(nu.y & 0xffff0000u)};
      float sgv[4];
#pragma unroll
      for (int j = 0; j < 4; ++j) { float f = cf[j] + mg0[j] * (pf[j] - cf[j]) + mg1[j] * (nf[j] - cf[j]); sgv[j] = __builtin_amdgcn_rcpf(1.f + __expf(-f)); }
      uint2 o; o.x = pack2(sgv[0], sgv[1]); o.y = pack2(sgv[2], sgv[3]);
      *(uint2*)&sgb[ti * 136 + 4 * gq] = o;
    }
    __syncthreads();
    f32x4 acc[2][4];
#pragma unroll
    for (int mt = 0; mt < 2; ++mt)
#pragma unroll
      for (int nt = 0; nt < 4; ++nt) acc[mt][nt] = (f32x4){0.f, 0.f, 0.f, 0.f};
#pragma unroll
    for (int mt = 0; mt < 2; ++mt)
#pragma unroll
      for (int ks = 0; ks < 4; ++ks) {
        const bf16x8 af = *(const bf16x8*)&sgb[(mt * 16 + l15) * 136 + ks * 32 + 8 * lq];
#pragma unroll
        for (int nt = 0; nt < 4; ++nt) acc[mt][nt] = __builtin_amdgcn_mfma_f32_16x16x32_bf16(af, gf[ks][nt], acc[mt][nt], 0, 0, 0);
      }
#pragma unroll
    for (int mt = 0; mt < 2; ++mt)
#pragma unroll
      for (int rg = 0; rg < 4; ++rg) {
        const int ti = mt * 16 + 4 * lq + rg; const int row = row0 + ti, pos = pos0 + ti;
        const bool hp = pos > 0, hn = pos < T - 1;
        const int offp = hp ? -EVC : 0, offn = hn ? EVC : 0;
        const u16* pr = P + (size_t)row * EVC + RW + wave * 64 + l15;
        const u16* yr = Y + (size_t)row * 1024 + wave * 64 + l15;
        u16 yv[4][2], cv[4][3], pv[4][3], nv[4][3];
#pragma unroll
        for (int nt = 0; nt < 4; ++nt) {
          yv[nt][0] = yr[nt * 16]; yv[nt][1] = yr[512 + nt * 16];
#pragma unroll
          for (int w = 0; w < 3; ++w) {
            cv[nt][w] = pr[w * 512 + nt * 16];
            pv[nt][w] = pr[w * 512 + nt * 16 + offp];
            nv[nt][w] = pr[w * 512 + nt * 16 + offn];
          }
        }
        float y[4], rs[4], ks_[4], vs[4];
        float ysum = 0.f, rksum = 0.f;
#pragma unroll
        for (int nt = 0; nt < 4; ++nt) {
          y[nt] = bf2f(yv[nt][0]) + bf2f(yv[nt][1]); ysum += y[nt];
          const float rc = bf2f(cv[nt][0]), kc = bf2f(cv[nt][1]), vc = bf2f(cv[nt][2]);
          const float pm = hp ? 1.f : 0.f, nm = hn ? 1.f : 0.f;
          rs[nt] = rc + mr0[nt] * (pm * bf2f(pv[nt][0]) - rc) + mr1[nt] * (nm * bf2f(nv[nt][0]) - rc);
          ks_[nt] = kc + mk0[nt] * (pm * bf2f(pv[nt][1]) - kc) + mk1[nt] * (nm * bf2f(nv[nt][1]) - kc);
          vs[nt] = vc + mv0[nt] * (pm * bf2f(pv[nt][2]) - vc) + mv1[nt] * (nm * bf2f(nv[nt][2]) - vc);
          rksum += rs[nt] * ks_[nt] * rkc[nt];
        }
        const float mean = row_sum16(ysum) * (1.f / 64.f);
        float vsum = 0.f;
#pragma unroll
        for (int nt = 0; nt < 4; ++nt) { y[nt] -= mean; vsum += y[nt] * y[nt]; }
        const float rstd = rsqrtf(row_sum16(vsum) * (1.f / 64.f) + 64e-5f);
        const float bsum = row_sum16(rksum);
        u16* orow = O + (size_t)row * D + 512 + wave * 64 + l15;
#pragma unroll
        for (int nt = 0; nt < 4; ++nt) orow[nt * 16] = f2bf((y[nt] * rstd * gnw[nt] + gnb[nt] + bsum * vs[nt]) * acc[mt][nt][rg]);
      }
    __syncthreads();
  }
}

__device__ void phase_final(const Params& p) {
  const int tid_ = otid(); const int lane = tid_ & 63, wave = tid_ >> 6;
  const float* fg = p.in[26];
  for (int row = obid() * 8 + wave; row < MLAT; row += gridDim.x * 8) {
    float4* xr = (float4*)(p.out + (size_t)row * D);
    float4 v[4]; float ss = 0.f;
#pragma unroll
    for (int q = 0; q < 4; ++q) { v[q] = xr[lane + q * 64]; ss += v[q].x * v[q].x + v[q].y * v[q].y + v[q].z * v[q].z + v[q].w * v[q].w; }
    ss = wave_sum(ss);
    float rstd = rsqrtf(ss * (1.f / 1024.f) + 1e-6f);
#pragma unroll
    for (int q = 0; q < 4; ++q) {
      float4 g = *(const float4*)(fg + (lane + q * 64) * 4);
      xr[lane + q * 64] = make_float4(v[q].x * rstd * g.x, v[q].y * rstd * g.y, v[q].z * rstd * g.z, v[q].w * rstd * g.w);
    }
  }
}

#define XB_TMO      128
#define XB_XCNT(j)  (256  + 64 * (j))
#define XB_XSUB(j)  (1280 + 64 * (j))
#define XB_XGEN(j)  (2304 + 64 * (j))
#define XB_TOP      3328
#define XB_TOPGEN   3392
#define XCD_BAR_WORDS 3456
#define XB_SPIN_CAP (1u << 18)
#define LAS __attribute__((address_space(3)))

__device__ __forceinline__ unsigned xb_ld(unsigned* p)              { return __hip_atomic_load(p, __ATOMIC_RELAXED, __HIP_MEMORY_SCOPE_AGENT); }
__device__ __forceinline__ unsigned xb_add(unsigned* p, unsigned v) { return __hip_atomic_fetch_add(p, v, __ATOMIC_RELAXED, __HIP_MEMORY_SCOPE_AGENT); }
__device__ __forceinline__ unsigned xb_xcc_id() { return (unsigned)__builtin_amdgcn_s_getreg((3 << 11) | 20) & 0xFu; }
#define XB_SPIN(cond, bar) do { unsigned _sp = 0; while (cond) { __builtin_amdgcn_s_sleep(1); \
    if ((++_sp & 255u) == 0u) { if (xb_ld(&(bar)[XB_TMO])) break; if (_sp > XB_SPIN_CAP) { atomicAdd(&(bar)[XB_TMO], 1u); break; } } } } while (0)

struct XcdBarrier {
    unsigned* bar; unsigned x;
    volatile LAS unsigned* st;
};

__device__ __forceinline__ XcdBarrier xcd_barrier_post(unsigned* bar, volatile LAS unsigned* st) {
    XcdBarrier b; b.bar = bar; b.x = xb_xcc_id(); b.st = st;
    if (threadIdx.x == 0) (void)xb_add(&bar[XB_XCNT(b.x)], 1u);
    return b;
}
__device__ __forceinline__ void xcd_barrier_complete(unsigned* bar, unsigned x, unsigned& nloc, unsigned& nx) {
    const unsigned G = gridDim.x * gridDim.y * gridDim.z;
    unsigned sum, cnt, mine, sp = 0u;
    for (;;) {
        sum = 0u; cnt = 0u; mine = 0u;
#pragma unroll
        for (unsigned j = 0; j < 16; ++j) { const unsigned c = xb_ld(&bar[XB_XCNT(j)]); sum += c; cnt += (c > 0u) ? 1u : 0u; mine = (j == x) ? c : mine; }
        if (sum == G) break;
        __builtin_amdgcn_s_sleep(1);
        if ((++sp & 255u) == 0u) { if (xb_ld(&bar[XB_TMO])) break; if (sp > XB_SPIN_CAP) { atomicAdd(&bar[XB_TMO], 1u); break; } }
    }
    nloc = mine > 0u ? mine : 1u; nx = cnt > 0u ? cnt : 1u;
}

__device__ __forceinline__ void xcd_barrier(const XcdBarrier& b) {
    asm volatile("s_waitcnt vmcnt(0)" ::: "memory");
    __syncthreads();
    if (threadIdx.x == 0) {
        unsigned* bar = b.bar;
        __builtin_amdgcn_s_waitcnt(0);
        unsigned nloc = b.st[0], nx = b.st[1];
        if (nloc == 0u) { xcd_barrier_complete(bar, b.x, nloc, nx); b.st[0] = nloc; b.st[1] = nx; }
        const unsigned old = xb_add(&bar[XB_XSUB(b.x)], 1u);
        const unsigned gen = old / nloc;
        if (old + 1u == (gen + 1u) * nloc) {
            __builtin_amdgcn_fence(__ATOMIC_RELEASE, "agent");
            asm volatile("s_waitcnt vmcnt(0)" ::: "memory");
            const unsigned og = xb_add(&bar[XB_TOP], 1u);
            const unsigned tg = og / nx;
            if (og + 1u == (tg + 1u) * nx) xb_add(&bar[XB_TOPGEN], 1u);
            else XB_SPIN(xb_ld(&bar[XB_TOPGEN]) == tg, bar);
            __builtin_amdgcn_fence(__ATOMIC_ACQUIRE, "agent");
            xb_add(&bar[XB_XGEN(b.x)], 1u);
            asm volatile("s_waitcnt vmcnt(0)" ::: "memory");
        } else {
            XB_SPIN(xb_ld(&bar[XB_XGEN(b.x)]) == gen, bar);
            __builtin_amdgcn_fence(__ATOMIC_ACQUIRE, "agent");
            asm volatile("s_waitcnt vmcnt(0)" ::: "memory");
        }
    }
    __syncthreads();
}


__device__ void run_phase(const Params& p, int ph, int rep) {
  if (ph == 0) { phase_setup(p); return; }
  if (ph == 1) { phase_mod(p); return; }
  if (ph == 50) { phase_final(p); return; }
  const int l = (ph - 2) / 12, s = (ph - 2) % 12;
  const bool even = !(l & 1); const int e = l >> 1;
  const int mrows_late = (l == 3) ? MLAT : MTOT;
  const float* modl = (const float*)(p.ws + WS_MOD) + (size_t)l * 9 * 9216;
  const u16* H = (const u16*)(p.ws + WS_H);
  u16* ACT = (u16*)(p.ws + WS_ACT);
  float* xctx = (float*)(p.ws + WS_XCTX);
  switch (s) {
    case 0: phase_prep(p, l, 0, MTOT); break;
    case 1: { EpiAct ep{ACT}; gemm_phase(H, (const u16*)(p.ws + WS_FFI) + (size_t)(l * 2 + 0) * 5632 * 1024, MTOT, 5632, 1024, ep); } break;
    case 2: { EpiRes ep{p.out, xctx, modl, 2, rep ? 0.5f : 0.f}; gemm_phase(ACT, (const u16*)(p.ws + WS_FFO) + (size_t)(l * 2 + 0) * 1024 * 2816, MTOT, 1024, 2816, ep); } break;
    case 3: phase_prep(p, l, 3, MTOT); break;
    case 4:
      if (even) { EpiP ep{ACT, EVC, EVC, 1.0f}; gemm_phase(H, (const u16*)(p.ws + WS_EVI) + (size_t)e * EVCP * 1024, MTOT, EVCP, 1024, ep); }
      else { EpiP ep{ACT, ODC, ODC, 1.0f}; gemm_phase(H, (const u16*)(p.ws + WS_ODI) + (size_t)e * ODC * 1024, MTOT, ODC, 1024, ep); }
      break;
    case 5: phase_feat(p, l); break;
    case 6: phase_mix(p, l, rep); break;
    case 7: if (even) phase_readout(p, e); break;
    case 8: { EpiRes ep{p.out, xctx, modl, 5, rep ? 1.0f : 0.f};
      gemm_phase(H, (const u16*)(p.ws + (even ? WS_EVO : WS_ODO)) + (size_t)e * 1024 * 1024, mrows_late, 1024, 1024, ep); } break;
    case 9: phase_prep(p, l, 6, mrows_late); break;
    case 10: { EpiAct ep{ACT}; gemm_phase(H, (const u16*)(p.ws + WS_FFI) + (size_t)(l * 2 + 1) * 5632 * 1024, mrows_late, 5632, 1024, ep); } break;
    case 11: { EpiRes ep{p.out, xctx, modl, 8, rep ? 0.5f : 0.f}; gemm_phase(ACT, (const u16*)(p.ws + WS_FFO) + (size_t)(l * 2 + 1) * 1024 * 2816, mrows_late, 1024, 2816, ep); } break;
  }
}

__global__ void __launch_bounds__(512, 2) mega(Params p, int ph_lo, int ph_hi) {
  cg::grid_group grid = cg::this_grid();
  volatile LAS unsigned* st = (volatile LAS unsigned*)(g_lds + 131072);
  XcdBarrier bar; bar.bar = (unsigned*)(p.ws + WS_BAR); bar.x = 0; bar.st = st;
  if (ph_hi - ph_lo > 1) {
    if (threadIdx.x < 2) st[threadIdx.x] = 0u;
    __syncthreads();
    bar = xcd_barrier_post((unsigned*)(p.ws + WS_BAR), st);
  }
  for (int ph = ph_lo; ph < ph_hi; ++ph) {
    int rep0 = 1;
#if DUP
    { bool dup = false;
      if (ph < 2) dup = (DUP & 32) != 0;
      else if (ph < 50) { int s_ = (ph - 2) % 12;
        dup = ((DUP & 1) && (s_ == 1 || s_ == 4 || s_ == 10)) || ((DUP & 2) && s_ == 6) || ((DUP & 4) && (s_ == 0 || s_ == 3 || s_ == 9)) ||
              ((DUP & 8) && (s_ == 5 || s_ == 7)) || ((DUP & 16) && (s_ == 2 || s_ == 8 || s_ == 11)); }
      if (dup) rep0 = 0; }
#endif
#pragma unroll 1
    for (int rep = rep0; rep < 2; ++rep) {
      run_phase(p, ph, rep);
      if (rep == 0 || ph + 1 < ph_hi) {
        if (ph == ph_lo && rep == 1) grid.sync();
        else xcd_barrier(bar);
      }
    }
  }
}

extern "C" void kernel_launch(void* const* d_in, const int* in_sizes, int n_in, void* d_out, int out_size, void* d_ws, size_t ws_size,
                              hipStream_t stream) {
  static int grid = 0;
  if (grid == 0) {
    if (ws_size < WS_END) { fprintf(stderr, "kernel_launch: workspace too small: %zu < %zu\n", ws_size, (size_t)WS_END); grid = -1; return; }
    hipFuncSetAttribute((const void*)mega, hipFuncAttributeMaxDynamicSharedMemorySize, LDS_BYTES);
    int dev = 0, cus = 0, per_cu = 0;
    hipGetDevice(&dev);
    hipDeviceGetAttribute(&cus, hipDeviceAttributeMultiprocessorCount, dev);
    hipOccupancyMaxActiveBlocksPerMultiprocessor(&per_cu, (const void*)mega, 512, LDS_BYTES);
    if (per_cu < 1) per_cu = 1;
    grid = cus * 1;
    (void)hipGetLastError();
  }
  if (grid < 0) return;
  Params p{};
  for (int i = 0; i < 27; ++i) p.in[i] = (const float*)d_in[i];
  p.out = (float*)d_out; p.ws = (unsigned char*)d_ws;
#if MEGA
  hipMemsetAsync((unsigned char*)d_ws + WS_BAR, 0, 16384, stream);
  int lo = 0, hi = NPH;
  void* args[] = {&p, &lo, &hi};
  hipError_t e = hipLaunchCooperativeKernel((const void*)mega, dim3(grid), dim3(512), args, LDS_BYTES, stream);
  if (e != hipSuccess) fprintf(stderr, "cooperative launch failed: %s\n", hipGetErrorString(e));
#else
  for (int ph = 0; ph < NPH; ++ph) {
    if (ph >= 2 && ph < 50) { int l = (ph - 2) / 12, s = (ph - 2) % 12; if (s == 7 && (l & 1)) continue; }
    hipLaunchKernelGGL(mega, dim3(grid), dim3(512), LDS_BYTES, stream, p, ph, ph + 1);
  }
#endif
}
```

```cpp
#include <hip/hip_runtime.h>
#include <hip/hip_cooperative_groups.h>
#include <cstdio>
namespace cg = cooperative_groups;

#ifndef MEGA
#define MEGA 1
#endif
#ifndef DUP
#define DUP 0
#endif
#ifndef DUPSKIP
#define DUPSKIP 0
#endif
#ifndef SCANMODE
#define SCANMODE 0
#endif

typedef unsigned short u16;
using bf16x8 = __attribute__((ext_vector_type(8))) short;
using f32x4  = __attribute__((ext_vector_type(4))) float;
using f32x16 = __attribute__((ext_vector_type(16))) float;
#define DI __device__ __forceinline__

constexpr int D = 1024, MLAT = 32768, MCTX = 2048, MTOT = 34816, NTOK = 4352;
constexpr int DFF = 2816, EVC = 2688, EVCP = 2816, ODC = 1536, RW = 768;
constexpr int NPH = 51;
constexpr int LDS_BYTES = 131072 + 64;

constexpr size_t WS_FFI = 0;
constexpr size_t WS_FFO = WS_FFI + (size_t)8 * 5632 * 1024 * 2;
constexpr size_t WS_EVI = WS_FFO + (size_t)8 * 1024 * 2816 * 2;
constexpr size_t WS_EVO = WS_EVI + (size_t)2 * 2816 * 1024 * 2;
constexpr size_t WS_ODI = WS_EVO + (size_t)2 * 1024 * 1024 * 2;
constexpr size_t WS_ODO = WS_ODI + (size_t)2 * 1536 * 1024 * 2;
constexpr size_t WS_MOD = WS_ODO + (size_t)2 * 1024 * 1024 * 2;
constexpr size_t WS_XCTX = WS_MOD + (size_t)4 * 9 * 9216 * 4;
constexpr size_t WS_H = WS_XCTX + (size_t)MCTX * D * 4;
constexpr size_t WS_ACT = WS_H + (size_t)MTOT * D * 2;
constexpr size_t WS_Q = WS_ACT + (size_t)MTOT * DFF * 2;
constexpr size_t WS_K = WS_Q + (size_t)8 * 16 * NTOK * 64 * 2;
constexpr size_t WS_VT = WS_K + (size_t)8 * 4 * NTOK * 64 * 2;
constexpr size_t WS_Y = WS_VT + (size_t)8 * 4 * NTOK * 64 * 2;
constexpr size_t WS_CNT = WS_Y + (size_t)MTOT * 2 * 512 * 2;
constexpr size_t WS_BAR = WS_CNT + 256;
constexpr size_t WS_END = WS_BAR + 16384;

struct Params {
  const float* in[27];
  float* out;
  unsigned char* ws;
};

extern __shared__ __attribute__((aligned(16))) unsigned char g_lds[];

DI int otid() { int t = threadIdx.x; asm volatile("" : "+v"(t)); return t; }
DI int obid() { int b = blockIdx.x; asm volatile("" : "+s"(b)); return b; }
DI u16 f2bf(float f) { unsigned u = __float_as_uint(f); u += 0x7fffu + ((u >> 16) & 1u); return (u16)(u >> 16); }
DI float bf2f(u16 h) { return __uint_as_float(((unsigned)h) << 16); }
DI unsigned pack2(float a, float b) { unsigned r; asm("v_cvt_pk_bf16_f32 %0, %1, %2" : "=v"(r) : "v"(a), "v"(b)); return r; }
template <int CTRL, int RMASK> DI float dpp_add(float v) {
  return v + __int_as_float(__builtin_amdgcn_update_dpp(0, __float_as_int(v), CTRL, RMASK, 0xF, RMASK == 0xF));
}
DI float row_sum16(float v) {
  v = dpp_add<0xB1, 0xF>(v); v = dpp_add<0x4E, 0xF>(v); v = dpp_add<0x141, 0xF>(v); v = dpp_add<0x140, 0xF>(v);
  return v;
}
DI float wave_sum(float v) {
  v = row_sum16(v);
  v = dpp_add<0x142, 0xA>(v); v = dpp_add<0x143, 0xC>(v);
  return __int_as_float(__builtin_amdgcn_readlane(__float_as_int(v), 63));
}
DI float* xrow(const Params& p, int row) {
  return row < MLAT ? p.out + (size_t)row * D : (float*)(p.ws + WS_XCTX) + (size_t)(row - MLAT) * D;
}

DI void convert_tile(const float* src, int ld_src, u16* dst, int ld_dst, int k0, int nsrc0, int ndst0) {
  float* t = (float*)g_lds;
  const int tid = otid();
#pragma unroll
  for (int it = 0; it < 2; ++it) {
    int idx = tid + it * 512; int i = idx >> 4, j4 = idx & 15;
    float4 v = *(const float4*)(src + (size_t)(k0 + i) * ld_src + nsrc0 + j4 * 4);
    t[(j4 * 4 + 0) * 65 + i] = v.x; t[(j4 * 4 + 1) * 65 + i] = v.y; t[(j4 * 4 + 2) * 65 + i] = v.z; t[(j4 * 4 + 3) * 65 + i] = v.w;
  }
  __syncthreads();
  int n = tid >> 3, kq = tid & 7;
  const float* r = t + n * 65 + kq * 8;
  uint4 o; o.x = pack2(r[0], r[1]); o.y = pack2(r[2], r[3]); o.z = pack2(r[4], r[5]); o.w = pack2(r[6], r[7]);
  *(uint4*)(dst + (size_t)(ndst0 + n) * ld_dst + k0 + kq * 8) = o;
  __syncthreads();
}

__device__ void phase_setup(const Params& p) {
  const int tid = otid();
  const int N_FFI = 8 * 16 * 88, N_FFO = 8 * 44 * 16, N_EVI = 2 * 16 * 42, N_EVO = 2 * 256, N_ODI = 2 * 16 * 24, N_ODO = 2 * 256;
  const int total = N_FFI + N_FFO + N_EVI + N_EVO + N_ODI + N_ODO;
  for (int it = obid(); it < total; it += gridDim.x) {
    int t = it;
    if (t < N_FFI) {
      int m = t / 1408, r = t % 1408; int kt = r & 15, nt = r >> 4;
      int nd = nt * 64; int t256 = nd >> 8, half = (nd >> 7) & 1, c0 = nd & 127;
      convert_tile(p.in[6] + (size_t)m * 1024 * 5632, 5632, (u16*)(p.ws + WS_FFI) + (size_t)m * 5632 * 1024, 1024, kt * 64, half * 2816 + t256 * 128 + c0, nd);
      continue;
    }
    t -= N_FFI;
    if (t < N_FFO) {
      int m = t / 704, r = t % 704; int kt = r % 44, nt = r / 44;
      convert_tile(p.in[7] + (size_t)m * 2816 * 1024, 1024, (u16*)(p.ws + WS_FFO) + (size_t)m * 1024 * 2816, 2816, kt * 64, nt * 64, nt * 64);
      continue;
    }
    t -= N_FFO;
    if (t < N_EVI) {
      int m = t / 672, r = t % 672; int kt = r & 15, nt = r >> 4;
      convert_tile(p.in[8] + (size_t)m * 1024 * EVC, EVC, (u16*)(p.ws + WS_EVI) + (size_t)m * EVCP * 1024, 1024, kt * 64, nt * 64, nt * 64);
      continue;
    }
    t -= N_EVI;
    if (t < N_EVO) {
      int m = t / 256, r = t % 256; int kt = r & 15, nt = r >> 4;
      convert_tile(p.in[9] + (size_t)m * 1024 * 1024, 1024, (u16*)(p.ws + WS_EVO) + (size_t)m * 1024 * 1024, 1024, kt * 64, nt * 64, nt * 64);
      continue;
    }
    t -= N_EVO;
    if (t < N_ODI) {
      int m = t / 384, r = t % 384; int kt = r & 15, nt = r >> 4;
      convert_tile(p.in[23] + (size_t)m * 1024 * ODC, ODC, (u16*)(p.ws + WS_ODI) + (size_t)m * ODC * 1024, 1024, kt * 64, nt * 64, nt * 64);
      continue;
    }
    t -= N_ODI;
    {
      int m = t / 256, r = t % 256; int kt = r & 15, nt = r >> 4;
      convert_tile(p.in[24] + (size_t)m * 1024 * 1024, 1024, (u16*)(p.ws + WS_ODO) + (size_t)m * 1024 * 1024, 1024, kt * 64, nt * 64, nt * 64);
    }
  }
  for (int i = obid() * 512 + tid; i < 2 * 128 * 1024 / 8; i += gridDim.x * 512) {
    int m = i / (128 * 128), r = i % (128 * 128);
    *(uint4*)((u16*)(p.ws + WS_EVI) + (size_t)m * EVCP * 1024 + (size_t)EVC * 1024 + (size_t)r * 8) = make_uint4(0, 0, 0, 0);
  }
  {
    const float4* xs = (const float4*)p.in[0]; float4* xd = (float4*)p.out;
    for (size_t i = (size_t)obid() * 512 + tid; i < (size_t)MLAT * D / 4; i += (size_t)gridDim.x * 512) xd[i] = xs[i];
    const float4* cs = (const float4*)p.in[2]; float4* cd = (float4*)(p.ws + WS_XCTX);
    for (size_t i = (size_t)obid() * 512 + tid; i < (size_t)MCTX * D / 4; i += (size_t)gridDim.x * 512) cd[i] = cs[i];
  }
  if (obid() == 0 && tid < 64) ((unsigned*)(p.ws + WS_CNT))[tid] = 0u;
}

__device__ void phase_mod(const Params& p) {
  const int tid = otid();
  float* sc = (float*)g_lds;
  float* red = sc + 9 * 1024;
  for (int i = tid; i < 9 * 1024; i += 512) {
    int e = i >> 10, k = i & 1023; float v = e < 8 ? p.in[1][e * 1024 + k] : p.in[3][k];
    sc[i] = v / (1.f + __expf(-v));
  }
  __syncthreads();
  float* mod = (float*)(p.ws + WS_MOD);
  for (int tile = obid(); tile < 576; tile += gridDim.x) {
    int l = tile / 144, cgp = tile % 144;
    int cl = tid & 63, kg = tid >> 6;
    const float* w = p.in[4] + (size_t)l * 1024 * 9216 + cgp * 64 + cl;
    float acc[9];
#pragma unroll
    for (int e = 0; e < 9; ++e) acc[e] = 0.f;
    for (int k = kg * 128; k < kg * 128 + 128; ++k) {
      float wv = w[(size_t)k * 9216];
#pragma unroll
      for (int e = 0; e < 9; ++e) acc[e] += sc[e * 1024 + k] * wv;
    }
#pragma unroll
    for (int e = 0; e < 9; ++e) red[(kg * 9 + e) * 64 + cl] = acc[e];
    __syncthreads();
    for (int o = tid; o < 576; o += 512) {
      int e = o >> 6, cc = o & 63; float s = 0.f;
#pragma unroll
      for (int k2 = 0; k2 < 8; ++k2) s += red[(k2 * 9 + e) * 64 + cc];
      mod[(size_t)(l * 9 + e) * 9216 + cgp * 64 + cc] = s + p.in[5][l * 9216 + cgp * 64 + cc];
    }
    __syncthreads();
  }
}

__device__ void phase_prep(const Params& p, int l, int sh, int nrows) {
  const int tid_ = otid(); const int lane = tid_ & 63, wave = tid_ >> 6;
  u16* H = (u16*)(p.ws + WS_H);
  const float* modl = (const float*)(p.ws + WS_MOD) + (size_t)l * 9 * 9216;
  for (int row = obid() * 16 + wave; row < nrows; row += gridDim.x * 16) {
    const float4* xr0 = (const float4*)xrow(p, row);
    const float4* xr1 = (const float4*)xrow(p, row + 8);
    int e = row < MLAT ? row >> 12 : 8;
    const float* m = modl + (size_t)e * 9216;
    float4 v[2][4]; float ss0 = 0.f, ss1 = 0.f;
#pragma unroll
    for (int q = 0; q < 4; ++q) { v[0][q] = xr0[lane + q * 64]; v[1][q] = xr1[lane + q * 64]; }
#pragma unroll
    for (int q = 0; q < 4; ++q) {
      ss0 += v[0][q].x * v[0][q].x + v[0][q].y * v[0][q].y + v[0][q].z * v[0][q].z + v[0][q].w * v[0][q].w;
      ss1 += v[1][q].x * v[1][q].x + v[1][q].y * v[1][q].y + v[1][q].z * v[1][q].z + v[1][q].w * v[1][q].w;
    }
    ss0 = wave_sum(ss0); ss1 = wave_sum(ss1);
    const float rstd0 = rsqrtf(ss0 * (1.f / 1024.f) + 1e-6f), rstd1 = rsqrtf(ss1 * (1.f / 1024.f) + 1e-6f);
#pragma unroll
    for (int q = 0; q < 4; ++q) {
      int col = (lane + q * 64) * 4;
      float4 s4 = *(const float4*)(m + sh * 1024 + col), c4 = *(const float4*)(m + (sh + 1) * 1024 + col);
      uint2 o;
      o.x = pack2(v[0][q].x * rstd0 * (1.f + c4.x) + s4.x, v[0][q].y * rstd0 * (1.f + c4.y) + s4.y);
      o.y = pack2(v[0][q].z * rstd0 * (1.f + c4.z) + s4.z, v[0][q].w * rstd0 * (1.f + c4.w) + s4.w);
      *(uint2*)(H + (size_t)row * D + col) = o;
      o.x = pack2(v[1][q].x * rstd1 * (1.f + c4.x) + s4.x, v[1][q].y * rstd1 * (1.f + c4.y) + s4.y);
      o.y = pack2(v[1][q].z * rstd1 * (1.f + c4.z) + s4.z, v[1][q].w * rstd1 * (1.f + c4.w) + s4.w);
      *(uint2*)(H + (size_t)(row + 8) * D + col) = o;
    }
  }
}

namespace pg8 {
#define PG8_LAS __attribute__((address_space(3)))
typedef unsigned short bf16_t;
typedef unsigned u32x4 __attribute__((ext_vector_type(4)));
constexpr int BM = 256, BK = 64, HALF = 128, HTB = HALF * BK * 2, STAGE_BYTES = 8 * HTB, NXCD = 8, WGM = 8;
__host__ __device__ __forceinline__ int lds_byte(int r, int c) { const int st = (r >> 4) * 2 + (c >> 5), rr = r & 15, cc = c & 31, ob = rr * 64 + cc * 2; return st * 1024 + (ob ^ (((ob >> 9) & 1) << 5)); }
__host__ __device__ __forceinline__ void stage_rc(int b, int& R, int& C) { const int st = b / 1024, sb = b % 1024, swz = sb ^ (((sb >> 9) & 1) << 5); R = (st >> 1) * 16 + swz / 64; C = (st & 1) * 32 + (swz % 64) / 2; }
__host__ __device__ __forceinline__ int perm32(int rho) { const int n = rho >> 4, i = rho & 15; return 8 * (i >> 2) + 4 * n + (i & 3); }
struct Unit { int pm, pn; };
struct Gemm { const bf16_t* A; const bf16_t* Bt; int M, N, K; };
struct StaticOrder {
    int nM, nN, nwg, G, c;
    __host__ __device__ void init(int M, int N, int G_, int c_) { nM = M / BM; nN = N / BM; nwg = nM * nN; G = G_; c = c_; }
    __host__ __device__ bool next(int i, Unit& u) const {
        const long L = (long)i * G + c; if (L >= nwg) return false;
        int wgid = (int)L; { const int q = nwg / NXCD, r = nwg % NXCD, xcd = wgid % NXCD, off = wgid / NXCD; wgid = (xcd < r ? xcd * (q + 1) : r * (q + 1) + (xcd - r) * q) + off; }
        const int nig = WGM * nN, gid = wgid / nig, fm = gid * WGM, gsz = (nM - fm) < WGM ? (nM - fm) : WGM;
        u.pm = fm + ((wgid % nig) % gsz); u.pn = (wgid % nig) / gsz; return true;
    }
    __device__ __forceinline__ void a_ready(const Unit&) const {}
    __device__ __forceinline__ void done(const Unit&) const {}
};
template <class Epi, class Sched, bool STAMP = false>
__device__ __forceinline__ void gemm_phase(PG8_LAS unsigned char* lds, const Gemm g, const Sched& S, const Epi& E, unsigned long long* stamps) {
    const int tid = otid(), wid = __builtin_amdgcn_readfirstlane(tid >> 6), lane = tid & 63, wr = wid >> 2, wc = wid & 3, fr = lane & 15, fq = lane >> 4;
    const int K = g.K, nt = K / BK;
    int ts_lo = 0, ts_hi = 0, nts = 0; const unsigned long long rt_entry = STAMP ? (unsigned long long)wall_clock64() : 0ull;
#define PG8_STAMP() do { if (STAMP && wid == 0 && nts < 64) { const unsigned long long _c = (unsigned long long)clock64(); \
        ts_lo = (lane == nts) ? (int)(unsigned)_c : ts_lo; ts_hi = (lane == nts) ? (int)(unsigned)(_c >> 32) : ts_hi; ++nts; } } while (0)
    PG8_STAMP();
    unsigned voffA[2], voffB[2];
#pragma unroll
    for (int i = 0; i < 2; ++i) { int R, C; stage_rc(tid * 16 + i * 8192, R, C); const int Rb = Epi::PERM ? ((R & ~31) + perm32(R & 31)) : R;
        voffA[i] = (unsigned)(R * K + C) * 2u; voffB[i] = (unsigned)(Rb * K + C) * 2u; }
    const size_t kstep = (size_t)(BK * 2);
    const size_t hstep = (size_t)HALF * K * 2;
    const size_t tstep = 2 * hstep;
    const unsigned ldsw = (unsigned)wid * 1024u;
    const int aoff = lds_byte(wr * 64 + fr, fq * 8), boff = lds_byte(wc * 32 + fr, fq * 8);
#define PG8_SA(b, h) (((b) * 2 + (h)) * HTB)
#define PG8_SB(b, h) ((4 + (b) * 2 + (h)) * HTB)
#define PG8_STAGE(bufoff, gbase, voff) do { _Pragma("unroll") for (int _i = 0; _i < 2; ++_i) \
        __builtin_amdgcn_global_load_lds((const unsigned*)((const char*)(gbase) + (voff)[_i]), (PG8_LAS unsigned*)(lds + (bufoff) + ldsw + _i * 8192), 16, 0, 0); } while (0)
#define PG8_LDA(dst, b, h) do { _Pragma("unroll") for (int m = 0; m < 4; ++m) _Pragma("unroll") for (int k = 0; k < 2; ++k) dst[m][k] = *(const PG8_LAS bf16x8*)(lds + PG8_SA(b, h) + aoff + m * 2048 + k * 1024); } while (0)
#define PG8_LDB(dst, b, h) do { _Pragma("unroll") for (int n = 0; n < 2; ++n) _Pragma("unroll") for (int k = 0; k < 2; ++k) dst[n][k] = *(const PG8_LAS bf16x8*)(lds + PG8_SB(b, h) + boff + n * 2048 + k * 1024); } while (0)
#define PG8_MMA(ai, bj, At, Bt) do { __builtin_amdgcn_s_setprio(1); _Pragma("unroll") for (int m = 0; m < 4; ++m) _Pragma("unroll") for (int n = 0; n < 2; ++n) _Pragma("unroll") for (int k = 0; k < 2; ++k) \
        acc[ai][bj][m][n] = __builtin_amdgcn_mfma_f32_16x16x32_bf16(Bt[n][k], At[m][k], acc[ai][bj][m][n], 0, 0, 0); __builtin_amdgcn_s_setprio(0); } while (0)
#define PG8_WAIT_V(n) asm volatile("s_waitcnt vmcnt(" #n ")" ::: "memory")
#define PG8_WAIT_L(n) asm volatile("s_waitcnt lgkmcnt(" #n ")" ::: "memory")
#define PG8_BAR __builtin_amdgcn_s_barrier()
#define PG8_SCHED __builtin_amdgcn_sched_barrier(0)
    Unit cur, nxt; int ui = 0;
    if (!S.next(0, cur)) return;
    f32x4 acc[2][2][4][2];
#pragma unroll
    for (int a = 0; a < 2; ++a)
#pragma unroll
        for (int b = 0; b < 2; ++b)
#pragma unroll
            for (int m = 0; m < 4; ++m)
#pragma unroll
                for (int n = 0; n < 2; ++n) acc[a][b][m][n] = (f32x4){0.f, 0.f, 0.f, 0.f};
    bf16x8 At[4][2], B0[2][2], B1[2][2];
    const char* cA = (const char*)g.A + (size_t)cur.pm * tstep; const char* cB = (const char*)g.Bt + (size_t)cur.pn * tstep;
    S.a_ready(cur);
    PG8_STAGE(PG8_SB(0, 0), cB, voffB); PG8_STAGE(PG8_SA(0, 0), cA, voffA); PG8_STAGE(PG8_SB(0, 1), cB + hstep, voffB); PG8_STAGE(PG8_SA(0, 1), cA + hstep, voffA);
    if (wr == 1) PG8_BAR;
    PG8_WAIT_V(4); PG8_BAR;
    PG8_STAGE(PG8_SB(1, 0), cB + kstep, voffB); PG8_STAGE(PG8_SA(1, 0), cA + kstep, voffA); PG8_STAGE(PG8_SB(1, 1), cB + hstep + kstep, voffB);
    PG8_WAIT_V(6); PG8_BAR;
    PG8_STAMP();
    for (;;) {
        const bool has_next = S.next(ui + 1, nxt);
        const char* nA = has_next ? (const char*)g.A + (size_t)nxt.pm * tstep : cA; const char* nB = has_next ? (const char*)g.Bt + (size_t)nxt.pn * tstep : cB;
        for (int t = 0; t < nt; t += 2) {
            const bool last = (t == nt - 2);
            const char* a1 = cA + (size_t)(t + 1) * kstep;
            const char* a2 = last ? nA : cA + (size_t)(t + 2) * kstep; const char* b2 = last ? nB : cB + (size_t)(t + 2) * kstep;
            const char* a3 = a2 + kstep; const char* b3 = b2 + kstep;
            if (last && has_next) S.a_ready(nxt);
            PG8_LDB(B0, 0, 0); PG8_SCHED; PG8_LDA(At, 0, 0); PG8_STAGE(PG8_SA(1, 1), a1 + hstep, voffA);
            PG8_WAIT_L(8); PG8_BAR; PG8_WAIT_L(0); PG8_MMA(0, 0, At, B0); PG8_BAR; PG8_SCHED;
            PG8_LDB(B1, 0, 1); PG8_STAGE(PG8_SB(0, 0), b2, voffB);
            PG8_BAR; PG8_WAIT_L(0); PG8_MMA(0, 1, At, B1); PG8_BAR;
            PG8_LDA(At, 0, 1); PG8_STAGE(PG8_SA(0, 0), a2, voffA);
            PG8_BAR; PG8_WAIT_L(0); PG8_MMA(1, 0, At, B0); PG8_BAR; PG8_SCHED;
            PG8_STAGE(PG8_SB(0, 1), b2 + hstep, voffB);
            PG8_WAIT_V(6); PG8_BAR; PG8_MMA(1, 1, At, B1); PG8_BAR;
            PG8_LDB(B0, 1, 0); PG8_SCHED; PG8_LDA(At, 1, 0); PG8_STAGE(PG8_SA(0, 1), a2 + hstep, voffA);
            PG8_WAIT_L(8); PG8_BAR; PG8_WAIT_L(0); PG8_MMA(0, 0, At, B0); PG8_BAR; PG8_SCHED;
            PG8_LDB(B1, 1, 1); PG8_STAGE(PG8_SB(1, 0), b3, voffB);
            PG8_BAR; PG8_WAIT_L(0); PG8_MMA(0, 1, At, B1); PG8_BAR;
            PG8_LDA(At, 1, 1); PG8_STAGE(PG8_SA(1, 0), a3, voffA);
            PG8_BAR; PG8_WAIT_L(0); PG8_MMA(1, 0, At, B0); PG8_BAR; PG8_SCHED;
            PG8_STAGE(PG8_SB(1, 1), b3 + hstep, voffB);
            PG8_WAIT_V(6); PG8_BAR; PG8_MMA(1, 1, At, B1); PG8_BAR;
        }
        PG8_STAMP();
        if constexpr (!Epi::AFTER_DRAIN) { E(acc, cur, wr, wc, fr, fq); S.done(cur); }
        PG8_STAMP();
        if (!has_next) break;
#pragma unroll
        for (int a = 0; a < 2; ++a)
#pragma unroll
            for (int b = 0; b < 2; ++b)
#pragma unroll
                for (int m = 0; m < 4; ++m)
#pragma unroll
                    for (int n = 0; n < 2; ++n) acc[a][b][m][n] = (f32x4){0.f, 0.f, 0.f, 0.f};
        cur = nxt; cA = nA; cB = nB; ++ui;
    }
    PG8_WAIT_V(0);
    if (wr == 0) PG8_BAR;
    PG8_BAR;
    if constexpr (Epi::AFTER_DRAIN) { E.fused(acc, cur, wr, wc, fr, fq, lds, wid, lane); S.done(cur); }
    PG8_STAMP();
    if (STAMP && wid == 0) { stamps[lane] = lane < nts ? (((unsigned long long)(unsigned)ts_hi << 32) | (unsigned)ts_lo) : 0ull;
        if (lane == 62) stamps[62] = rt_entry; if (lane == 63) stamps[63] = (unsigned long long)wall_clock64(); }
#undef PG8_STAMP
#undef PG8_SA
#undef PG8_SB
#undef PG8_STAGE
#undef PG8_LDA
#undef PG8_LDB
#undef PG8_MMA
#undef PG8_WAIT_V
#undef PG8_WAIT_L
#undef PG8_BAR
#undef PG8_SCHED
}
}

struct EpiAct {
  static constexpr bool PERM = true, AFTER_DRAIN = false;
  u16* act;
  DI void operator()(const f32x4 (&acc)[2][2][4][2], const pg8::Unit& u, int wr, int wc, int fr, int fq) const {
    const int row0 = u.pm * 256 + wr * 64 + fr, col0 = u.pn * 128 + wc * 32 + 8 * fq;
#pragma unroll
    for (int ai = 0; ai < 2; ++ai)
#pragma unroll
      for (int m = 0; m < 4; ++m) {
        u16* rowp = act + (size_t)(row0 + ai * 128 + m * 16) * DFF + col0;
        float o[8];
#pragma unroll
        for (int n = 0; n < 2; ++n)
#pragma unroll
          for (int j = 0; j < 4; ++j) { float g = acc[ai][0][m][n][j], up = acc[ai][1][m][n][j]; o[n * 4 + j] = g * up * __builtin_amdgcn_rcpf(1.f + __builtin_amdgcn_exp2f(-1.4426950408889634f * g)); }
        uint4 w; w.x = pack2(o[0], o[1]); w.y = pack2(o[2], o[3]); w.z = pack2(o[4], o[5]); w.w = pack2(o[6], o[7]);
        *(uint4*)rowp = w;
      }
  }
};
struct EpiRes {
  static constexpr bool PERM = false, AFTER_DRAIN = false;
  float* xlat; float* xctx; const float* modl; int gidx; float coef;
  DI void operator()(const f32x4 (&acc)[2][2][4][2], const pg8::Unit& u, int wr, int wc, int fr, int fq) const {
    const int brow = u.pm * 256;
    const int e = brow < MLAT ? brow >> 12 : 8;
    float* xb = (brow < MLAT ? xlat + (size_t)brow * D : xctx + (size_t)(brow - MLAT) * D) + (size_t)(wr * 64 + fr) * D;
    const int col0 = u.pn * 256 + wc * 32 + 4 * fq;
    const float* mg = modl + (size_t)e * 9216 + gidx * 1024 + col0;
    f32x4 gm[2][2];
#pragma unroll
    for (int bj = 0; bj < 2; ++bj)
#pragma unroll
      for (int n = 0; n < 2; ++n) gm[bj][n] = *(const f32x4*)(mg + bj * 128 + n * 16) * coef;
#pragma unroll
    for (int ai = 0; ai < 2; ++ai)
#pragma unroll
      for (int m = 0; m < 4; ++m) {
        float* rowp = xb + (size_t)(ai * 128 + m * 16) * D + col0;
#pragma unroll
        for (int bj = 0; bj < 2; ++bj)
#pragma unroll
          for (int n = 0; n < 2; ++n) {
            f32x4* xp = (f32x4*)(rowp + bj * 128 + n * 16);
            *xp = *xp + gm[bj][n] * acc[ai][bj][m][n];
          }
      }
  }
};
struct EpiP {
  static constexpr bool PERM = true, AFTER_DRAIN = false;
  u16* P; int ld; int nvalid; float one;
  DI void operator()(const f32x4 (&acc)[2][2][4][2], const pg8::Unit& u, int wr, int wc, int fr, int fq) const {
    const int row0 = u.pm * 256 + wr * 64 + fr, col0 = u.pn * 256 + wc * 32 + 8 * fq;
#pragma unroll
    for (int ai = 0; ai < 2; ++ai)
#pragma unroll
      for (int m = 0; m < 4; ++m) {
        u16* rowp = P + (size_t)(row0 + ai * 128 + m * 16) * ld + col0;
#pragma unroll
        for (int bj = 0; bj < 2; ++bj) {
          if (col0 + bj * 128 < nvalid) {
            const f32x4 v0 = acc[ai][bj][m][0] * one, v1 = acc[ai][bj][m][1] * one;
            uint4 w; w.x = pack2(v0[0], v0[1]); w.y = pack2(v0[2], v0[3]); w.z = pack2(v1[0], v1[1]); w.w = pack2(v1[2], v1[3]);
            *(uint4*)(rowp + bj * 128) = w;
          }
        }
      }
  }
};

template <class Epi>
DI void gemm_phase(const u16* A, const u16* Bt, int Mrows, int N, int K, const Epi& epi) {
  pg8::Gemm g{A, Bt, Mrows, N, K};
  pg8::StaticOrder S; S.init(Mrows, N, (int)gridDim.x, obid());
  pg8::gemm_phase<Epi, pg8::StaticOrder, false>((PG8_LAS unsigned char*)g_lds, g, S, epi, nullptr);
}

template <bool EVEN>
__device__ void phase_feat_t(const Params& p, int l) {
  const int tid = otid(), lane = tid & 63, wave = tid >> 6;
  const int e = l >> 1;
  constexpr int NQ = EVEN ? 8 : 16, NKV = EVEN ? 2 : 4, ld = EVEN ? EVC : ODC;
  constexpr int nch = NQ + 2 * NKV, NIT = nch / 2;
  const u16* P = (const u16*)(p.ws + WS_ACT);
  u16* Q = (u16*)(p.ws + WS_Q); u16* Kd = (u16*)(p.ws + WS_K); u16* Vt = (u16*)(p.ws + WS_VT);
  u16* vts = (u16*)g_lds;
  const int i = lane & 31;
  const float qg0 = p.in[10][e * 64 + 2 * i], qg1 = p.in[10][e * 64 + 2 * i + 1];
  const float kg0 = p.in[11][e * 64 + 2 * i], kg1 = p.in[11][e * 64 + 2 * i + 1];
  const float invf = exp2f(-(float)(i & 15) * (13.287712379549449f / 16.f));
  for (int g = obid(); g < MTOT / 64; g += gridDim.x) {
    const int row0 = g * 64; const bool lat = row0 < MLAT;
    int b, tok0;
    if (lat) { b = row0 >> 12; tok0 = row0 & 4095; } else { int r = row0 - MLAT; b = r >> 8; tok0 = 4096 + (r & 255); }
#pragma unroll 2
    for (int tj = 0; tj < 8; ++tj) {
      const int ti = wave + 8 * tj;
      const int row = row0 + ti, tok = tok0 + ti;
      unsigned pv[NIT];
      const u16* prow = P + (size_t)row * ld + (lane >> 5) * 64 + 2 * i;
#pragma unroll
      for (int it = 0; it < NIT; ++it) pv[it] = *(const unsigned*)(prow + it * 128);
      float cs = 1.f, sn = 0.f;
      if (lat) { float pos = (i < 16) ? (float)(tok >> 6) : (float)(tok & 63); float ang = pos * invf; cs = __cosf(ang); sn = __sinf(ang); }
#pragma unroll
      for (int it = 0; it < NIT; ++it) {
        const int ch = it * 2 + (lane >> 5);
        float x0 = bf2f((u16)(pv[it] & 0xffff)), x1 = bf2f((u16)(pv[it] >> 16));
        const bool isq = it * 2 < NQ, isk = !isq && it * 2 < NQ + NKV;
        if (EVEN && (isq || isk)) {
          float ss = row_sum16(x0 * x0 + x1 * x1);
          ss += __shfl_xor(ss, 16);
          float r = rsqrtf(ss * (1.f / 64.f) + 1e-6f);
          x0 *= r * (isq ? qg0 : kg0); x1 *= r * (isq ? qg1 : kg1);
        }
        if (isq || isk) {
          float y0 = x0 * cs - x1 * sn, y1 = x0 * sn + x1 * cs;
          if (isq) {
            const float sc = 0.125f * 1.4426950408889634f;
            *(unsigned*)(Q + ((size_t)(b * NQ + ch) * NTOK + tok) * 64 + 2 * i) = pack2(y0 * sc, y1 * sc);
          } else {
            *(unsigned*)(Kd + ((size_t)(b * NKV + (ch - NQ)) * NTOK + tok) * 64 + 2 * i) = pack2(y0, y1);
          }
        } else {
          int vr = (ch - NQ - NKV) * 64 + 2 * i;
          vts[vr * 72 + ti] = f2bf(x0); vts[(vr + 1) * 72 + ti] = f2bf(x1);
        }
      }
    }
    __syncthreads();
    for (int idx = tid; idx < NKV * 64 * 8; idx += 512) {
      int r = idx >> 3, seg = idx & 7; int kvh = r >> 6, d = r & 63;
      uint4 val = *(const uint4*)&vts[r * 72 + seg * 8];
      *(uint4*)(Vt + ((size_t)(b * NKV + kvh) * 64 + d) * NTOK + tok0 + seg * 8) = val;
    }
    __syncthreads();
  }
}
__device__ void phase_feat(const Params& p, int l) {
  if (l & 1) phase_feat_t<false>(p, l); else phase_feat_t<true>(p, l);
}

DI bf16x8 pack8(const f32x16& x, int s) {
  uint4 r;
  r.x = pack2(x[8 * s + 0], x[8 * s + 1]); r.y = pack2(x[8 * s + 2], x[8 * s + 3]);
  r.z = pack2(x[8 * s + 4], x[8 * s + 5]); r.w = pack2(x[8 * s + 6], x[8 * s + 7]);
  return __builtin_bit_cast(bf16x8, r);
}

__device__ void attn_item(const Params& p, int NQ, int NKV, int b, int kvh, int q0, bool windowed, bool has_sink, const float* sinkp) {
  const int tid = otid(), lane = tid & 63, wave = tid >> 6, r = lane & 31, h = lane >> 5;
  const u16* Q = (const u16*)(p.ws + WS_Q); const u16* Kd = (const u16*)(p.ws + WS_K); const u16* Vt = (const u16*)(p.ws + WS_VT);
  u16* O = (u16*)(p.ws + WS_H);
  const int head = kvh * 4 + (wave >> 1);
  const int qtok = q0 + (wave & 1) * 32 + r;
  const bool is_ctx = q0 >= 4096;
  const u16* qp = Q + ((size_t)(b * NQ + head) * NTOK + qtok) * 64;
  bf16x8 qf[4];
#pragma unroll
  for (int kk = 0; kk < 4; ++kk) qf[kk] = *(const bf16x8*)(qp + kk * 16 + h * 8);
  const u16* Kb = Kd + (size_t)(b * NKV + kvh) * NTOK * 64;
  const u16* Vb = Vt + (size_t)(b * NKV + kvh) * 64 * NTOK;
  int nt, nwin = 0, wlo = 0;
  if (is_ctx) { nt = 4; wlo = 4096; nwin = 0; }
  else if (windowed) { wlo = q0 - 128 < 128 ? 128 : q0 - 128; int whi = q0 + 192 > 4096 ? 4096 : q0 + 192; nwin = (whi - wlo) >> 6; nt = nwin + 4; }
  else { nt = 68; }
#define KSTART(it) (is_ctx ? 4096 + (it) * 64 : (windowed ? ((it) < nwin ? wlo + (it) * 64 : 4096 + ((it) - nwin) * 64) : (it) * 64))
  u16* Ks = (u16*)g_lds; u16* Vs = Ks + 2 * 64 * 72;
  const int lrow = tid >> 3, lseg = tid & 7;
  uint4 kreg, vreg;
  { int ks = KSTART(0);
    kreg = *(const uint4*)(Kb + (size_t)(ks + lrow) * 64 + lseg * 8);
    vreg = *(const uint4*)(Vb + (size_t)lrow * NTOK + ks + lseg * 8);
    *(uint4*)&Ks[lrow * 72 + lseg * 8] = kreg; *(uint4*)&Vs[lrow * 72 + lseg * 8] = vreg; }
  __syncthreads();
  f32x16 ot[2];
#pragma unroll
  for (int i = 0; i < 16; ++i) { ot[0][i] = 0.f; ot[1][i] = 0.f; }
  float mrun = -1e30f, lsum = 0.f;
  if (windowed && !is_ctx) { int nph = qtok + 129 - 4096; if (nph > 0) { mrun = 0.f; lsum = (float)nph; } }
  for (int it = 0; it < nt; ++it) {
    const int cur = it & 1;
    const u16* Kc = Ks + cur * 64 * 72; const u16* Vc = Vs + cur * 64 * 72;
    if (it + 1 < nt) { int ks = KSTART(it + 1);
      kreg = *(const uint4*)(Kb + (size_t)(ks + lrow) * 64 + lseg * 8);
      vreg = *(const uint4*)(Vb + (size_t)lrow * NTOK + ks + lseg * 8); }
    f32x16 st[2];
#pragma unroll
    for (int kt = 0; kt < 2; ++kt) {
#pragma unroll
      for (int i = 0; i < 16; ++i) st[kt][i] = 0.f;
#pragma unroll
      for (int kk = 0; kk < 4; ++kk) {
        bf16x8 kf = *(const bf16x8*)&Kc[(kt * 32 + r) * 72 + kk * 16 + h * 8];
        st[kt] = __builtin_amdgcn_mfma_f32_32x32x16_bf16(kf, qf[kk], st[kt], 0, 0, 0);
      }
    }
    if (windowed && it < nwin) {
      const int ks = KSTART(it);
#pragma unroll
      for (int kt = 0; kt < 2; ++kt)
#pragma unroll
        for (int i = 0; i < 16; ++i) {
          int key = ks + kt * 32 + (i & 3) + 8 * (i >> 2) + 4 * h;
          int dlt = key - qtok; dlt = dlt < 0 ? -dlt : dlt;
          if (dlt > 128) st[kt][i] = -1e30f;
        }
    }
    float mx = -1e30f;
#pragma unroll
    for (int kt = 0; kt < 2; ++kt)
#pragma unroll
      for (int i = 0; i < 16; ++i) mx = fmaxf(mx, st[kt][i]);
    mx = fmaxf(mx, __shfl_xor(mx, 32));
    const float mnew = fmaxf(mrun, mx);
    const float alpha = __builtin_amdgcn_exp2f(mrun - mnew);
    float rs = 0.f;
#pragma unroll
    for (int kt = 0; kt < 2; ++kt)
#pragma unroll
      for (int i = 0; i < 16; ++i) {
        float sv = st[kt][i];
        float pe = sv <= -1e29f ? 0.f : __builtin_amdgcn_exp2f(sv - mnew);
        st[kt][i] = pe; rs += pe;
      }
    rs += __shfl_xor(rs, 32);
    lsum = lsum * alpha + rs;
    mrun = mnew;
#pragma unroll
    for (int i = 0; i < 16; ++i) { ot[0][i] *= alpha; ot[1][i] *= alpha; }
#pragma unroll
    for (int kt = 0; kt < 2; ++kt)
#pragma unroll
      for (int s = 0; s < 2; ++s) {
        bf16x8 pf = pack8(st[kt], s);
#pragma unroll
        for (int db = 0; db < 2; ++db) {
          const u16* vp = &Vc[(db * 32 + r) * 72 + kt * 32 + 16 * s + 4 * h];
          uint2 v0 = *(const uint2*)vp, v1 = *(const uint2*)(vp + 8);
          uint4 vv = make_uint4(v0.x, v0.y, v1.x, v1.y);
          bf16x8 vf = __builtin_bit_cast(bf16x8, vv);
          ot[db] = __builtin_amdgcn_mfma_f32_32x32x16_bf16(vf, pf, ot[db], 0, 0, 0);
        }
      }
    if (it + 1 < nt) {
      u16* Kn = Ks + (cur ^ 1) * 64 * 72; u16* Vn = Vs + (cur ^ 1) * 64 * 72;
      *(uint4*)&Kn[lrow * 72 + lseg * 8] = kreg; *(uint4*)&Vn[lrow * 72 + lseg * 8] = vreg;
    }
    __syncthreads();
  }
#undef KSTART
  if (has_sink) lsum += __builtin_amdgcn_exp2f(sinkp[head] * 1.4426950408889634f - mrun);
  const float inv = 1.f / lsum;
  const size_t orow = is_ctx ? (size_t)MLAT + b * 256 + (qtok - 4096) : (size_t)b * 4096 + qtok;
  u16* op = O + orow * D + head * 64;
#pragma unroll
  for (int db = 0; db < 2; ++db)
#pragma unroll
    for (int g = 0; g < 4; ++g) {
      uint2 o;
      o.x = pack2(ot[db][4 * g + 0] * inv, ot[db][4 * g + 1] * inv);
      o.y = pack2(ot[db][4 * g + 2] * inv, ot[db][4 * g + 3] * inv);
      *(uint2*)(op + db * 32 + 8 * g + 4 * h) = o;
    }
}

DI void lbar() { asm volatile("s_waitcnt lgkmcnt(0)\n\ts_barrier" ::: "memory"); }
DI void bbar() { asm volatile("s_barrier" ::: "memory"); }
DI void lbar1() { asm volatile("s_waitcnt lgkmcnt(1)\n\ts_barrier" ::: "memory"); }
DI float fast_tanh(float x) { float e = __expf(2.f * x); return 1.f - 2.f / (e + 1.f); }
DI float dot16(const f32x4 (&s)[4], const f32x4& a0, const f32x4& a1, const f32x4& a2, const f32x4& a3) {
  f32x4 t = s[0] * a0; t += s[1] * a1; t += s[2] * a2; t += s[3] * a3;
  return (t[0] + t[1]) + (t[2] + t[3]);
}
__device__ void scan_chain(const Params& p, int e, int chain, int rep) {
  const int tid = otid(), lane = tid & 63, wave = __builtin_amdgcn_readfirstlane(tid >> 6);
  const int b = chain >> 4, h = (chain >> 1) & 7, d = chain & 1;
  const u16* P = (const u16*)(p.ws + WS_ACT);
  u16* Y = (u16*)(p.ws + WS_Y);
  float* sb0 = (float*)g_lds;
  float* bg0 = sb0 + 2 * 6144;
  float* part = bg0 + 2 * 128;
  float* yp0 = part + 512;
  float* tk = yp0 + 2 * 4096;
  u16* ttwb = (u16*)(tk + 1024);
  u16* talb = ttwb + 16 * 72;
  float* mus = tk + 1024 + 1152;
  const float* mu = p.in[12] + (size_t)e * 2 * 1920;
  auto chunk_geo = [&](int ci, int& t0, int& T, size_t& rowbase) {
    if (ci < 16) { T = 256; rowbase = (size_t)MLAT + b * 256; t0 = d ? 240 - ci * 16 : ci * 16; }
    else { T = 4096; rowbase = (size_t)b * 4096; int cj = ci - 16; t0 = d ? 4080 - cj * 16 : cj * 16; }
  };
  for (int i = tid; i < 640; i += 512) {
    int which = i / 320, r = i % 320; int seg = r >> 6, c = r & 63;
    int colb = seg == 0 ? h * 64 : seg == 1 ? 512 + h * 64 : seg == 2 ? 1024 + h * 64 : seg == 3 ? 1536 + d * 64 : 1664 + d * 64;
    mus[i] = mu[which * 1920 + colb + c];
  }
  lbar();
  if (wave < 4) {
    __builtin_amdgcn_s_setprio(3);
    f32x4 S[4];
#pragma unroll
    for (int j = 0; j < 4; ++j) S[j] = (f32x4){0.f, 0.f, 0.f, 0.f};
#pragma unroll 1
    for (int k = 0; k <= 272; ++k) {
      lbar();
      if (k == 0 || (SCANMODE >= 1 && rep == 0)) {
#pragma unroll 1
        for (int t = 0; t < 16; ++t) lbar();
        continue;
      }
      const float* sb = sb0 + ((k - 1) & 1) * 6144; const float* bg = bg0 + ((k - 1) & 1) * 128; float* yp = yp0 + ((k - 1) & 1) * 4096;
      const float* sbw = sb + wave * 16;
      { const f32x4* kp = (const f32x4*)(sbw + 4 * 64);
        part[wave * 64 + lane] = dot16(S, kp[0], kp[1], kp[2], kp[3]); }
      f32x4 wA[4], nA[4]; float viA; float2 gA;
      f32x4 wB[4], nB[4]; float viB; float2 gB;
#define LOADSTEP(t_, X) do { const float* s_ = sbw + (t_) * 384; \
        _Pragma("unroll") for (int j = 0; j < 4; ++j) { w##X[j] = *(const f32x4*)(s_ + 1 * 64 + 4 * j); n##X[j] = *(const f32x4*)(s_ + 384 + 4 * 64 + 4 * j); } \
        vi##X = sb[(t_) * 384 + 3 * 64 + lane]; g##X = *(const float2*)&bg[((t_) * 4 + wave) * 2]; } while (0)
#define STEP(t_, X, Y_) do { \
        lbar1(); \
        const float* pp = part + ((t_) & 1) * 256; \
        float q0 = pp[lane], q1 = pp[64 + lane], q2 = pp[128 + lane], q3 = pp[192 + lane]; \
        f32x4 b_[4], k_[4], r_[4]; \
        { const float* s_ = sbw + (t_) * 384; \
          _Pragma("unroll") for (int j = 0; j < 4; ++j) { b_[j] = *(const f32x4*)(s_ + 5 * 64 + 4 * j); k_[j] = *(const f32x4*)(s_ + 2 * 64 + 4 * j); } \
          _Pragma("unroll") for (int j = 0; j < 4; ++j) r_[j] = *(const f32x4*)(s_ + 0 * 64 + 4 * j); } \
        if ((t_) < 15) LOADSTEP((t_) + 1, Y_); \
        f32x4 Dv[4]; \
        _Pragma("unroll") for (int j = 0; j < 4; ++j) Dv[j] = S[j] * w##X[j]; \
        float A = dot16(Dv, n##X[0], n##X[1], n##X[2], n##X[3]); \
        float sa = (q0 + q1) + (q2 + q3); \
        if ((t_) < 15) part[(((t_) + 1) & 1) * 256 + wave * 64 + lane] = A - sa * g##X.x + vi##X * g##X.y; \
        asm volatile("" ::: "memory");     \
        _Pragma("unroll") for (int j = 0; j < 4; ++j) S[j] = Dv[j] - b_[j] * sa + k_[j] * vi##X; \
        yp[((t_) * 4 + wave) * 64 + lane] = dot16(S, r_[0], r_[1], r_[2], r_[3]); } while (0)
      LOADSTEP(0, A);
#pragma unroll 1
      for (int t = 0; t < 16; t += 2) { STEP(t, A, B); STEP(t + 1, B, A); }
#undef LOADSTEP
#undef STEP
    }
    __builtin_amdgcn_s_setprio(0);
  } else {
    const int pw = wave - 4;
    const int cB = pw * 16 + (lane & 15);
    bf16x8 wfW[2], wfA[2];
    { const float* W = p.in[14] + (size_t)(e * 2 + d) * 64 * 512 + h * 64 + cB;
      const float* Am = p.in[16] + (size_t)(e * 2 + d) * 64 * 512 + h * 64 + cB;
#pragma unroll
      for (int ks = 0; ks < 2; ++ks)
#pragma unroll
        for (int j = 0; j < 8; ++j) { size_t ro = (size_t)(ks * 32 + 8 * (lane >> 4) + j) * 512; wfW[ks][j] = (short)f2bf(W[ro]); wfA[ks][j] = (short)f2bf(Am[ro]); } }
    const float kkc = p.in[18][e * 512 + h * 64 + lane];
    const float kacB = p.in[19][e * 512 + h * 64 + cB];
    const float w0cB = p.in[13][(e * 2 + d) * 512 + h * 64 + cB], a0cB = p.in[15][(e * 2 + d) * 512 + h * 64 + cB];
    float m0[5], m1[5];
#pragma unroll
    for (int seg = 0; seg < 5; ++seg) { m0[seg] = mus[seg * 64 + lane]; m1[seg] = mus[320 + seg * 64 + lane]; }
    u16 pvP[20], pvC[20], pvN[20];
    int t0n = 0, Tn = 1; const u16* rowp0 = P;
#define LOADGEO(ci_) do { size_t rbn_; chunk_geo((ci_), t0n, Tn, rbn_); rowp0 = P + (rbn_ + (size_t)t0n) * EVC + RW; } while (0)
#define LOADITEM(u_, seg_) do { \
      const int i_ = pw + 4 * (u_); const int rel_ = d ? 15 - i_ : i_; const int pos_ = t0n + rel_; \
      const int colb_ = (seg_) == 0 ? h * 64 : (seg_) == 1 ? 512 + h * 64 : (seg_) == 2 ? 1024 + h * 64 : (seg_) == 3 ? 1536 + d * 64 : 1664 + d * 64; \
      const u16* sp_ = rowp0 + (rel_ * EVC + colb_);     \
        \
      pvC[(u_) * 5 + (seg_)] = sp_[lane]; pvP[(u_) * 5 + (seg_)] = (sp_ - (pos_ > 0 ? EVC : 0))[lane]; \
      pvN[(u_) * 5 + (seg_)] = (sp_ + (pos_ < Tn - 1 ? EVC : 0))[lane]; } while (0)
#define STEPA(u_, seg_) do { const int i_ = pw + 4 * (u_); const int posa_ = d ? ta0 + 15 - i_ : ta0 + i_; \
      const float cur_ = bf2f(pvC[(u_) * 5 + (seg_)]), prv_ = posa_ > 0 ? bf2f(pvP[(u_) * 5 + (seg_)]) : 0.f, nxt_ = posa_ < Ta - 1 ? bf2f(pvN[(u_) * 5 + (seg_)]) : 0.f; \
      const float f_ = cur_ + m0[(seg_)] * (prv_ - cur_) + m1[(seg_)] * (nxt_ - cur_); \
      if ((seg_) == 0) sb[(i_ * 6 + 0) * 64 + lane] = f_; \
      else if ((seg_) == 1) { tk[i_ * 64 + lane] = f_; float kn_ = f_ * kkc; float ss_ = wave_sum(kn_ * kn_); sb[(i_ * 6 + 4) * 64 + lane] = kn_ * rsqrtf(ss_ + 1e-6f); } \
      else if ((seg_) == 2) sb[(i_ * 6 + 3) * 64 + lane] = f_; \
      else if ((seg_) == 3) ttwb[i_ * 72 + lane] = f2bf(fast_tanh(f_)); \
      else talb[i_ * 72 + lane] = f2bf(f_); } while (0)
    LOADGEO(0);
#pragma unroll
    for (int u = 0; u < 4; ++u)
#pragma unroll
      for (int seg = 0; seg < 5; ++seg) LOADITEM(u, seg);
#pragma unroll 1
    for (int k = 0; k <= 272; ++k) {
      float* sb = sb0 + (k & 1) * 6144; float* bg = bg0 + (k & 1) * 128; const float* ypf = yp0 + (k & 1) * 4096;
      const bool prep = k < 272 && !(SCANMODE == 2 && rep == 0);
      const bool nxt = k + 1 < 272;
      int ta0 = 0, Ta = 1; { size_t rba_; if (k < 272) chunk_geo(k, ta0, Ta, rba_); }
      lbar();
      if (prep) { STEPA(0, 0); STEPA(0, 1); }
      bbar();
      if (prep) { STEPA(0, 2); STEPA(0, 3); }
      bbar();
      if (prep) { STEPA(0, 4); STEPA(1, 0); }
      bbar();
      if (prep) { STEPA(1, 1); STEPA(1, 2); }
      bbar();
      if (prep) { STEPA(1, 3); STEPA(1, 4); }
      bbar();
      if (prep) { STEPA(2, 0); STEPA(2, 1); }
      bbar();
      if (prep) { STEPA(2, 2); STEPA(2, 3); }
      bbar();
      if (prep) { STEPA(2, 4); STEPA(3, 0); }
      bbar();
      if (prep) { STEPA(3, 1); STEPA(3, 2); }
      bbar();
      if (prep) { STEPA(3, 3); STEPA(3, 4); }
      lbar();
      if (prep) {
        const int ao = (lane & 15) * 72 + 8 * (lane >> 4);
        bf16x8 t0_ = *(const bf16x8*)(ttwb + ao), t1_ = *(const bf16x8*)(ttwb + ao + 32);
        bf16x8 l0_ = *(const bf16x8*)(talb + ao), l1_ = *(const bf16x8*)(talb + ao + 32);
        f32x4 accW = (f32x4){0.f, 0.f, 0.f, 0.f}, accA = (f32x4){0.f, 0.f, 0.f, 0.f};
        accW = __builtin_amdgcn_mfma_f32_16x16x32_bf16(t0_, wfW[0], accW, 0, 0, 0);
        accW = __builtin_amdgcn_mfma_f32_16x16x32_bf16(t1_, wfW[1], accW, 0, 0, 0);
        accA = __builtin_amdgcn_mfma_f32_16x16x32_bf16(l0_, wfA[0], accA, 0, 0, 0);
        accA = __builtin_amdgcn_mfma_f32_16x16x32_bf16(l1_, wfA[1], accA, 0, 0, 0);
#pragma unroll
        for (int rg = 0; rg < 4; ++rg) {
          const int i = 4 * (lane >> 4) + rg;
          float xx = -(w0cB + accW[rg]);
          float sp = fmaxf(xx, 0.f) + __logf(1.f + __expf(-fabsf(xx)));
          float ee = __expf(-sp - 0.5f);
          sb[(i * 6 + 1) * 64 + cB] = __expf(-ee);
          float a = __builtin_amdgcn_rcpf(1.f + __expf(-(a0cB + accA[rg])));
          const float kdv = tk[i * 64 + cB] * (1.f + (a - 1.f) * kacB);
          const float bv = sb[(i * 6 + 4) * 64 + cB] * a;
          sb[(i * 6 + 2) * 64 + cB] = kdv;
          sb[(i * 6 + 5) * 64 + cB] = bv;
          const float kkn = i < 15 ? sb[((i + 1) * 6 + 4) * 64 + cB] : 0.f;
          const float bb = row_sum16(bv * kkn), gg = row_sum16(kdv * kkn);
          if ((lane & 15) == 0 && i < 15) { bg[(i * 4 + pw) * 2] = bb; bg[(i * 4 + pw) * 2 + 1] = gg; }
        }
      }
      bbar();
      if (nxt) { LOADGEO(k + 1); LOADITEM(0, 0); LOADITEM(0, 1); LOADITEM(0, 2); LOADITEM(0, 3); LOADITEM(0, 4);
                 LOADITEM(1, 0); LOADITEM(1, 1); LOADITEM(1, 2); LOADITEM(1, 3); LOADITEM(1, 4); }
      bbar();
      if (nxt) { LOADITEM(2, 0); LOADITEM(2, 1); LOADITEM(2, 2); LOADITEM(2, 3); LOADITEM(2, 4);
                 LOADITEM(3, 0); LOADITEM(3, 1); LOADITEM(3, 2); LOADITEM(3, 3); LOADITEM(3, 4); }
      bbar();
      if (k >= 2) {
        int t0, T; size_t rowbase; chunk_geo(k - 2, t0, T, rowbase);
#pragma unroll
        for (int u = 0; u < 4; ++u) {
          const int s = pw * 4 + u;
          float yv = (ypf[(s * 4 + 0) * 64 + lane] + ypf[(s * 4 + 1) * 64 + lane]) + (ypf[(s * 4 + 2) * 64 + lane] + ypf[(s * 4 + 3) * 64 + lane]);
          int pos = d ? t0 + 15 - s : t0 + s;
          Y[((rowbase + pos) * 2 + d) * 512 + h * 64 + lane] = f2bf(yv);
        }
      }
      bbar();
      bbar();
      bbar();
    }
#undef LOADITEM
#undef LOADGEO
#undef STEPA
  }
  lbar();
  {
    const float* ypf = yp0 + (271 & 1) * 4096;
    int t0, T; size_t rowbase; chunk_geo(271, t0, T, rowbase);
#pragma unroll
    for (int u = 0; u < 2; ++u) {
      const int s = wave + 8 * u;
      float yv = (ypf[(s * 4 + 0) * 64 + lane] + ypf[(s * 4 + 1) * 64 + lane]) + (ypf[(s * 4 + 2) * 64 + lane] + ypf[(s * 4 + 3) * 64 + lane]);
      int pos = d ? t0 + 15 - s : t0 + s;
      Y[((rowbase + pos) * 2 + d) * 512 + h * 64 + lane] = f2bf(yv);
    }
  }
  lbar();
}

__device__ void phase_mix(const Params& p, int l, int rep) {
  const bool even = !(l & 1); const int e = l >> 1;
  if (even && !(rep == 0 && DUPSKIP == 2)) { for (int ch = obid(); ch < 128; ch += gridDim.x) scan_chain(p, e, ch, rep); }
  if (rep == 0 && DUPSKIP == 1) return;
  const int NQ = even ? 8 : 16, NKV = even ? 2 : 4;
  const int nlat = 8 * NKV * 64, nctx = (l == 3) ? 0 : 8 * NKV * 4;
  unsigned* cnt = (unsigned*)(p.ws + WS_CNT) + l + (rep ? 0 : 8);
  volatile int* slot = (volatile int*)(g_lds + 40960);
  const float* sinkp = even ? nullptr : p.in[25] + e * 16;
  for (;;) {
    __syncthreads();
    if (otid() == 0) *slot = (int)atomicAdd(cnt, 1u);
    __syncthreads();
    int item = *slot;
    if (item >= nlat + nctx) break;
    int b, kvh, q0;
    if (item < nlat) { int qt = item & 63; int r = item >> 6; kvh = r % NKV; b = r / NKV; q0 = qt * 64; }
    else { int it2 = item - nlat; int qt = it2 & 3; int r = it2 >> 2; kvh = r % NKV; b = r / NKV; q0 = 4096 + qt * 64; }
    attn_item(p, NQ, NKV, b, kvh, q0, !even, !even, sinkp);
  }
}

__device__ void phase_readout(const Params& p, int e) {
  const int tid = otid(), lane = tid & 63, wave = __builtin_amdgcn_readfirstlane(tid >> 6);
  const u16* P = (const u16*)(p.ws + WS_ACT);
  const u16* Y = (const u16*)(p.ws + WS_Y);
  u16* O = (u16*)(p.ws + WS_H);
  u16* sgb = (u16*)g_lds;
  const float* mu = p.in[12] + (size_t)e * 2 * 1920;
  const float* g2 = p.in[17] + (size_t)e * 128 * 512;
  const int l15 = lane & 15, lq = lane >> 4;
  bf16x8 gf[4][4];
#pragma unroll
  for (int ks = 0; ks < 4; ++ks)
#pragma unroll
    for (int nt = 0; nt < 4; ++nt)
#pragma unroll
      for (int j = 0; j < 8; ++j) gf[ks][nt][j] = (short)f2bf(g2[(size_t)(ks * 32 + 8 * lq + j) * 512 + wave * 64 + nt * 16 + l15]);
  float gnw[4], gnb[4], rkc[4], mr0[4], mr1[4], mk0[4], mk1[4], mv0[4], mv1[4];
#pragma unroll
  for (int nt = 0; nt < 4; ++nt) {
    const int c = wave * 64 + nt * 16 + l15;
    gnw[nt] = p.in[21][e * 512 + c]; gnb[nt] = p.in[22][e * 512 + c]; rkc[nt] = p.in[20][e * 512 + c];
    mr0[nt] = mu[c]; mr1[nt] = mu[1920 + c]; mk0[nt] = mu[512 + c]; mk1[nt] = mu[1920 + 512 + c]; mv0[nt] = mu[1024 + c]; mv1[nt] = mu[1920 + 1024 + c];
  }
  const int gq = tid & 31, gt = tid >> 5;
  float mg0[4], mg1[4];
#pragma unroll
  for (int j = 0; j < 4; ++j) { mg0[j] = mu[1792 + 4 * gq + j]; mg1[j] = mu[1920 + 1792 + 4 * gq + j]; }
  for (int tile = obid(); tile < MTOT / 32; tile += gridDim.x) {
    const int row0 = tile * 32; const bool lat = row0 < MLAT;
    const int T = lat ? 4096 : 256; const int pos0 = lat ? (row0 & 4095) : ((row0 - MLAT) & 255);
#pragma unroll
    for (int u = 0; u < 2; ++u) {
      const int ti = gt + 16 * u; const int row = row0 + ti, pos = pos0 + ti;
      const u16* gp = P + (size_t)row * EVC + RW + 1792 + 4 * gq;
      const uint2 cu = *(const uint2*)gp;
      const uint2 pu = pos > 0 ? *(const uint2*)(gp - EVC) : make_uint2(0u, 0u);
      const uint2 nu = pos < T - 1 ? *(const uint2*)(gp + EVC) : make_uint2(0u, 0u);
      float cf[4] = {__uint_as_float(cu.x << 16), __uint_as_float(cu.x & 0xffff0000u), __uint_as_float(cu.y << 16), __uint_as_float(cu.y & 0xffff0000u)};
      float pf[4] = {__uint_as_float(pu.x << 16), __uint_as_float(pu.x & 0xffff0000u), __uint_as_float(pu.y << 16), __uint_as_float(pu.y & 0xffff0000u)};
      float nf[4] = {__uint_as_float(nu.x << 16), __uint_as_float(nu.x & 0xffff0000u), __uint_as_float(nu.y << 16), __uint_as_float(nu.y & 0xffff0000u)};
      float sgv[4];
#pragma unroll
      for (int j = 0; j < 4; ++j) { float f = cf[j] + mg0[j] * (pf[j] - cf[j]) + mg1[j] * (nf[j] - cf[j]); sgv[j] = __builtin_amdgcn_rcpf(1.f + __expf(-f)); }
      uint2 o; o.x = pack2(sgv[0], sgv[1]); o.y = pack2(sgv[2], sgv[3]);
      *(uint2*)&sgb[ti * 136 + 4 * gq] = o;
    }
    __syncthreads();
    f32x4 acc[2][4];
#pragma unroll
    for (int mt = 0; mt < 2; ++mt)
#pragma unroll
      for (int nt = 0; nt < 4; ++nt) acc[mt][nt] = (f32x4){0.f, 0.f, 0.f, 0.f};
#pragma unroll
    for (int mt = 0; mt < 2; ++mt)
#pragma unroll
      for (int ks = 0; ks < 4; ++ks) {
        const bf16x8 af = *(const bf16x8*)&sgb[(mt * 16 + l15) * 136 + ks * 32 + 8 * lq];
#pragma unroll
        for (int nt = 0; nt < 4; ++nt) acc[mt][nt] = __builtin_amdgcn_mfma_f32_16x16x32_bf16(af, gf[ks][nt], acc[mt][nt], 0, 0, 0);
      }
#pragma unroll
    for (int mt = 0; mt < 2; ++mt)
#pragma unroll
      for (int rg = 0; rg < 4; ++rg) {
        const int ti = mt * 16 + 4 * lq + rg; const int row = row0 + ti, pos = pos0 + ti;
        const bool hp = pos > 0, hn = pos < T - 1;
        const int offp = hp ? -EVC : 0, offn = hn ? EVC : 0;
        const u16* pr = P + (size_t)row * EVC + RW + wave * 64 + l15;
        const u16* yr = Y + (size_t)row * 1024 + wave * 64 + l15;
        u16 yv[4][2], cv[4][3], pv[4][3], nv[4][3];
#pragma unroll
        for (int nt = 0; nt < 4; ++nt) {
          yv[nt][0] = yr[nt * 16]; yv[nt][1] = yr[512 + nt * 16];
#pragma unroll
          for (int w = 0; w < 3; ++w) {
            cv[nt][w] = pr[w * 512 + nt * 16];
            pv[nt][w] = pr[w * 512 + nt * 16 + offp];
            nv[nt][w] = pr[w * 512 + nt * 16 + offn];
          }
        }
        float y[4], rs[4], ks_[4], vs[4];
        float ysum = 0.f, rksum = 0.f;
#pragma unroll
        for (int nt = 0; nt < 4; ++nt) {
          y[nt] = bf2f(yv[nt][0]) + bf2f(yv[nt][1]); ysum += y[nt];
          const float rc = bf2f(cv[nt][0]), kc = bf2f(cv[nt][1]), vc = bf2f(cv[nt][2]);
          const float pm = hp ? 1.f : 0.f, nm = hn ? 1.f : 0.f;
          rs[nt] = rc + mr0[nt] * (pm * bf2f(pv[nt][0]) - rc) + mr1[nt] * (nm * bf2f(nv[nt][0]) - rc);
          ks_[nt] = kc + mk0[nt] * (pm * bf2f(pv[nt][1]) - kc) + mk1[nt] * (nm * bf2f(nv[nt][1]) - kc);
          vs[nt] = vc + mv0[nt] * (pm * bf2f(pv[nt][2]) - vc) + mv1[nt] * (nm * bf2f(nv[nt][2]) - vc);
          rksum += rs[nt] * ks_[nt] * rkc[nt];
        }
        const float mean = row_sum16(ysum) * (1.f / 64.f);
        float vsum = 0.f;
#pragma unroll
        for (int nt = 0; nt < 4; ++nt) { y[nt] -= mean; vsum += y[nt] * y[nt]; }
        const float rstd = rsqrtf(row_sum16(vsum) * (1.f / 64.f) + 64e-5f);
        const float bsum = row_sum16(rksum);
        u16* orow = O + (size_t)row * D + 512 + wave * 64 + l15;
#pragma unroll
        for (int nt = 0; nt < 4; ++nt) orow[nt * 16] = f2bf((y[nt] * rstd * gnw[nt] + gnb[nt] + bsum * vs[nt]) * acc[mt][nt][rg]);
      }
    __syncthreads();
  }
}

__device__ void phase_final(const Params& p) {
  const int tid_ = otid(); const int lane = tid_ & 63, wave = tid_ >> 6;
  const float* fg = p.in[26];
  for (int row = obid() * 8 + wave; row < MLAT; row += gridDim.x * 8) {
    float4* xr = (float4*)(p.out + (size_t)row * D);
    float4 v[4]; float ss = 0.f;
#pragma unroll
    for (int q = 0; q < 4; ++q) { v[q] = xr[lane + q * 64]; ss += v[q].x * v[q].x + v[q].y * v[q].y + v[q].z * v[q].z + v[q].w * v[q].w; }
    ss = wave_sum(ss);
    float rstd = rsqrtf(ss * (1.f / 1024.f) + 1e-6f);
#pragma unroll
    for (int q = 0; q < 4; ++q) {
      float4 g = *(const float4*)(fg + (lane + q * 64) * 4);
      xr[lane + q * 64] = make_float4(v[q].x * rstd * g.x, v[q].y * rstd * g.y, v[q].z * rstd * g.z, v[q].w * rstd * g.w);
    }
  }
}

#define XB_TMO      128
#define XB_XCNT(j)  (256  + 64 * (j))
#define XB_XSUB(j)  (1280 + 64 * (j))
#define XB_XGEN(j)  (2304 + 64 * (j))
#define XB_TOP      3328
#define XB_TOPGEN   3392
#define XCD_BAR_WORDS 3456
#define XB_SPIN_CAP (1u << 18)
#define LAS __attribute__((address_space(3)))

__device__ __forceinline__ unsigned xb_ld(unsigned* p)              { return __hip_atomic_load(p, __ATOMIC_RELAXED, __HIP_MEMORY_SCOPE_AGENT); }
__device__ __forceinline__ unsigned xb_add(unsigned* p, unsigned v) { return __hip_atomic_fetch_add(p, v, __ATOMIC_RELAXED, __HIP_MEMORY_SCOPE_AGENT); }
__device__ __forceinline__ unsigned xb_xcc_id() { return (unsigned)__builtin_amdgcn_s_getreg((3 << 11) | 20) & 0xFu; }
#define XB_SPIN(cond, bar) do { unsigned _sp = 0; while (cond) { __builtin_amdgcn_s_sleep(1); \
    if ((++_sp & 255u) == 0u) { if (xb_ld(&(bar)[XB_TMO])) break; if (_sp > XB_SPIN_CAP) { atomicAdd(&(bar)[XB_TMO], 1u); break; } } } } while (0)

struct XcdBarrier {
    unsigned* bar; unsigned x;
    volatile LAS unsigned* st;
};

__device__ __forceinline__ XcdBarrier xcd_barrier_post(unsigned* bar, volatile LAS unsigned* st) {
    XcdBarrier b; b.bar = bar; b.x = xb_xcc_id(); b.st = st;
    if (threadIdx.x == 0) (void)xb_add(&bar[XB_XCNT(b.x)], 1u);
    return b;
}
__device__ __forceinline__ void xcd_barrier_complete(unsigned* bar, unsigned x, unsigned& nloc, unsigned& nx) {
    const unsigned G = gridDim.x * gridDim.y * gridDim.z;
    unsigned sum, cnt, mine, sp = 0u;
    for (;;) {
        sum = 0u; cnt = 0u; mine = 0u;
#pragma unroll
        for (unsigned j = 0; j < 16; ++j) { const unsigned c = xb_ld(&bar[XB_XCNT(j)]); sum += c; cnt += (c > 0u) ? 1u : 0u; mine = (j == x) ? c : mine; }
        if (sum == G) break;
        __builtin_amdgcn_s_sleep(1);
        if ((++sp & 255u) == 0u) { if (xb_ld(&bar[XB_TMO])) break; if (sp > XB_SPIN_CAP) { atomicAdd(&bar[XB_TMO], 1u); break; } }
    }
    nloc = mine > 0u ? mine : 1u; nx = cnt > 0u ? cnt : 1u;
}

__device__ __forceinline__ void xcd_barrier(const XcdBarrier& b) {
    asm volatile("s_waitcnt vmcnt(0)" ::: "memory");
    __syncthreads();
    if (threadIdx.x == 0) {
        unsigned* bar = b.bar;
        __builtin_amdgcn_s_waitcnt(0);
        unsigned nloc = b.st[0], nx = b.st[1];
        if (nloc == 0u) { xcd_barrier_complete(bar, b.x, nloc, nx); b.st[0] = nloc; b.st[1] = nx; }
        const unsigned old = xb_add(&bar[XB_XSUB(b.x)], 1u);
        const unsigned gen = old / nloc;
        if (old + 1u == (gen + 1u) * nloc) {
            __builtin_amdgcn_fence(__ATOMIC_RELEASE, "agent");
            asm volatile("s_waitcnt vmcnt(0)" ::: "memory");
            const unsigned og = xb_add(&bar[XB_TOP], 1u);
            const unsigned tg = og / nx;
            if (og + 1u == (tg + 1u) * nx) xb_add(&bar[XB_TOPGEN], 1u);
            else XB_SPIN(xb_ld(&bar[XB_TOPGEN]) == tg, bar);
            __builtin_amdgcn_fence(__ATOMIC_ACQUIRE, "agent");
            xb_add(&bar[XB_XGEN(b.x)], 1u);
            asm volatile("s_waitcnt vmcnt(0)" ::: "memory");
        } else {
            XB_SPIN(xb_ld(&bar[XB_XGEN(b.x)]) == gen, bar);
            __builtin_amdgcn_fence(__ATOMIC_ACQUIRE, "agent");
            asm volatile("s_waitcnt vmcnt(0)" ::: "memory");
        }
    }
    __syncthreads();
}


__device__ void run_phase(const Params& p, int ph, int rep) {
  if (ph == 0) { phase_setup(p); __syncthreads(); phase_mod(p); return; }
  if (ph == 1) return;
  if (ph == 50) { phase_final(p); return; }
  const int l = (ph - 2) / 12, s = (ph - 2) % 12;
  const bool even = !(l & 1); const int e = l >> 1;
  const int mrows_late = (l == 3) ? MLAT : MTOT;
  const float* modl = (const float*)(p.ws + WS_MOD) + (size_t)l * 9 * 9216;
  const u16* H = (const u16*)(p.ws + WS_H);
  u16* ACT = (u16*)(p.ws + WS_ACT);
  float* xctx = (float*)(p.ws + WS_XCTX);
  switch (s) {
    case 0: phase_prep(p, l, 0, MTOT); break;
    case 1: { EpiAct ep{ACT}; gemm_phase(H, (const u16*)(p.ws + WS_FFI) + (size_t)(l * 2 + 0) * 5632 * 1024, MTOT, 5632, 1024, ep); } break;
    case 2: { EpiRes ep{p.out, xctx, modl, 2, rep ? 0.5f : 0.f}; gemm_phase(ACT, (const u16*)(p.ws + WS_FFO) + (size_t)(l * 2 + 0) * 1024 * 2816, MTOT, 1024, 2816, ep); } break;
    case 3: phase_prep(p, l, 3, MTOT); break;
    case 4:
      if (even) { EpiP ep{ACT, EVC, EVC, 1.0f}; gemm_phase(H, (const u16*)(p.ws + WS_EVI) + (size_t)e * EVCP * 1024, MTOT, EVCP, 1024, ep); }
      else { EpiP ep{ACT, ODC, ODC, 1.0f}; gemm_phase(H, (const u16*)(p.ws + WS_ODI) + (size_t)e * ODC * 1024, MTOT, ODC, 1024, ep); }
      break;
    case 5: phase_feat(p, l); break;
    case 6: phase_mix(p, l, rep); break;
    case 7: if (even) phase_readout(p, e); break;
    case 8: { EpiRes ep{p.out, xctx, modl, 5, rep ? 1.0f : 0.f};
      gemm_phase(H, (const u16*)(p.ws + (even ? WS_EVO : WS_ODO)) + (size_t)e * 1024 * 1024, mrows_late, 1024, 1024, ep); } break;
    case 9: phase_prep(p, l, 6, mrows_late); break;
    case 10: { EpiAct ep{ACT}; gemm_phase(H, (const u16*)(p.ws + WS_FFI) + (size_t)(l * 2 + 1) * 5632 * 1024, mrows_late, 5632, 1024, ep); } break;
    case 11: { EpiRes ep{p.out, xctx, modl, 8, rep ? 0.5f : 0.f}; gemm_phase(ACT, (const u16*)(p.ws + WS_FFO) + (size_t)(l * 2 + 1) * 1024 * 2816, mrows_late, 1024, 2816, ep); } break;
  }
}

__global__ void __launch_bounds__(512, 2) mega(Params p, int ph_lo, int ph_hi) {
  cg::grid_group grid = cg::this_grid();
  volatile LAS unsigned* st = (volatile LAS unsigned*)(g_lds + 131072);
  XcdBarrier bar; bar.bar = (unsigned*)(p.ws + WS_BAR); bar.x = 0; bar.st = st;
  if (ph_hi - ph_lo > 1) {
    if (threadIdx.x < 2) st[threadIdx.x] = 0u;
    __syncthreads();
    bar = xcd_barrier_post((unsigned*)(p.ws + WS_BAR), st);
  }
  for (int ph = ph_lo; ph < ph_hi; ++ph) {
    int rep0 = 1;
#if DUP
    { bool dup = false;
      if (ph < 2) dup = (DUP & 32) != 0;
      else if (ph < 50) { int s_ = (ph - 2) % 12;
        dup = ((DUP & 1) && (s_ == 1 || s_ == 4 || s_ == 10)) || ((DUP & 2) && s_ == 6) || ((DUP & 4) && (s_ == 0 || s_ == 3 || s_ == 9)) ||
              ((DUP & 8) && (s_ == 5 || s_ == 7)) || ((DUP & 16) && (s_ == 2 || s_ == 8 || s_ == 11)); }
      if (dup) rep0 = 0; }
#endif
    if (ph == 1) continue;
#pragma unroll 1
    for (int rep = rep0; rep < 2; ++rep) {
      run_phase(p, ph, rep);
      if (rep == 0 || ph + 1 < ph_hi) {
        if (ph == ph_lo && rep == 1) grid.sync();
        else xcd_barrier(bar);
      }
    }
  }
}

extern "C" void kernel_launch(void* const* d_in, const int* in_sizes, int n_in, void* d_out, int out_size, void* d_ws, size_t ws_size,
                              hipStream_t stream) {
  static int grid = 0;
  if (grid == 0) {
    if (ws_size < WS_END) { fprintf(stderr, "kernel_launch: workspace too small: %zu < %zu\n", ws_size, (size_t)WS_END); grid = -1; return; }
    hipFuncSetAttribute((const void*)mega, hipFuncAttributeMaxDynamicSharedMemorySize, LDS_BYTES);
    int dev = 0, cus = 0, per_cu = 0;
    hipGetDevice(&dev);
    hipDeviceGetAttribute(&cus, hipDeviceAttributeMultiprocessorCount, dev);
    hipOccupancyMaxActiveBlocksPerMultiprocessor(&per_cu, (const void*)mega, 512, LDS_BYTES);
    if (per_cu < 1) per_cu = 1;
    grid = cus * 1;
    (void)hipGetLastError();
  }
  if (grid < 0) return;
  Params p{};
  for (int i = 0; i < 27; ++i) p.in[i] = (const float*)d_in[i];
  p.out = (float*)d_out; p.ws = (unsigned char*)d_ws;
#if MEGA
  hipMemsetAsync((unsigned char*)d_ws + WS_BAR, 0, 16384, stream);
  int lo = 0, hi = NPH;
  void* args[] = {&p, &lo, &hi};
  hipError_t e = hipLaunchCooperativeKernel((const void*)mega, dim3(grid), dim3(512), args, LDS_BYTES, stream);
  if (e != hipSuccess) fprintf(stderr, "cooperative launch failed: %s\n", hipGetErrorString(e));
#else
  for (int ph = 0; ph < NPH; ++ph) {
    if (ph >= 2 && ph < 50) { int l = (ph - 2) / 12, s = (ph - 2) % 12; if (s == 7 && (l & 1)) continue; }
    hipLaunchKernelGGL(mega, dim3(grid), dim3(512), LDS_BYTES, stream, p, ph, ph + 1);
  }
#endif
}
```
